# Optimizing an MI355X kernel written in HIP

```python
import jax
import jax.numpy as jnp
from jax import lax
import numpy as np

D_MODEL = 1024
BATCH = 2
SEQ = 8192
DEPTH = 2

D_MIX = D_MODEL
D_GROUP = D_MIX // 4
HEAD_DIM = 64
N_HEADS = D_GROUP // HEAD_DIM
Q_BLOCK = 128
RWKV_LORA = 32
CONV_WIDTH = 4
LRU_C = 8.0
RMS_EPS = 1e-6
GN_EPS = 64e-5
N_RWKV_SHIFT = 3 * D_GROUP + 2 * RWKV_LORA
N_IN = 14 * D_GROUP + N_HEADS + 2 * RWKV_LORA

kernel_name = "hybrid_fox_stickbreak_rwkv7_rglru"


def rms_norm(x, g):
    x32 = x.astype(jnp.float32)
    y = x32 * lax.rsqrt(jnp.mean(x32 * x32, axis=-1, keepdims=True) + RMS_EPS)
    return (y * g.astype(jnp.float32)).astype(x.dtype)


def split_columns(p):
    G, H = D_GROUP, N_HEADS
    sizes = [G, G, G, G, H, G, G, G, G, N_RWKV_SHIFT, G, G, G]
    cuts, acc = [], 0
    for n in sizes[:-1]:
        acc += n
        cuts.append(acc)
    return jnp.split(p, cuts, axis=-1)


def to_heads(t):
    b, s, _ = t.shape
    return t.reshape(b, s, N_HEADS, HEAD_DIM).transpose(0, 2, 1, 3).astype(jnp.float32)


def query_blocks(t):
    b, h, s = t.shape[:3]
    t = t.reshape((b, h, s // Q_BLOCK, Q_BLOCK) + t.shape[3:])
    return jnp.moveaxis(t, 2, 0)


def merge_blocks(o):
    nb, b, h, q, d = o.shape
    return o.transpose(1, 0, 3, 2, 4).reshape(b, nb * q, h * d)


def forgetting_attention(q, k, v, log_f):
    s = q.shape[2]
    scale = HEAD_DIM ** -0.5
    cum = jnp.cumsum(log_f, axis=-1)
    key_pos = jnp.arange(s)

    def block(args):
        qb, cb, i = args
        q_pos = i * Q_BLOCK + jnp.arange(Q_BLOCK)
        logits = (jnp.einsum('bhqd,bhkd->bhqk', qb, k) * scale
                  + cb[..., None] - cum[:, :, None, :])
        logits = jnp.where(key_pos[None, :] <= q_pos[:, None], logits, -jnp.inf)
        return jnp.einsum('bhqk,bhkd->bhqd', jax.nn.softmax(logits, axis=-1), v)

    out = lax.map(block, (query_blocks(q), query_blocks(cum), jnp.arange(s // Q_BLOCK)))
    return merge_blocks(out)


def stick_breaking_attention(q, k, v):
    s = q.shape[2]
    scale = HEAD_DIM ** -0.5
    key_pos = jnp.arange(s)

    def block(args):
        qb, i = args
        q_pos = i * Q_BLOCK + jnp.arange(Q_BLOCK)
        z = jnp.einsum('bhqd,bhkd->bhqk', qb, k) * scale
        mask = key_pos[None, :] < q_pos[:, None]
        log_keep = jnp.where(mask, jax.nn.log_sigmoid(-z), 0.0)
        log_rest = lax.cumsum(log_keep, axis=3, reverse=True) - log_keep
        att = jnp.where(mask, jnp.exp(jax.nn.log_sigmoid(z) + log_rest), 0.0)
        return jnp.einsum('bhqk,bhkd->bhqd', att, v)

    out = lax.map(block, (query_blocks(q), jnp.arange(s // Q_BLOCK)))
    return merge_blocks(out)


def rwkv7_time_mix(p, mu, w0, w2, a0, a2, k_k, k_a, r_k, ln_g, ln_b):
    b, s, _ = p.shape
    G, R = D_GROUP, RWKV_LORA
    p = p.astype(jnp.float32)
    prev = jnp.pad(p, ((0, 0), (1, 0), (0, 0)))[:, :-1]
    p = p + (prev - p) * mu
    r, k, v, wl, al = jnp.split(p, [G, 2 * G, 3 * G, 3 * G + R], axis=-1)
    w = -jax.nn.softplus(-(w0 + jnp.tanh(wl) @ w2)) - 0.5
    decay = jnp.exp(-jnp.exp(w))
    a = jax.nn.sigmoid(a0 + al @ a2)
    hs = lambda t: t.reshape(b, s, N_HEADS, HEAD_DIM)
    kk = hs(k * k_k)
    kk = kk * lax.rsqrt(jnp.maximum(jnp.sum(kk * kk, axis=-1, keepdims=True), 1e-12))
    k = hs(k * (1.0 + (a - 1.0) * k_a))
    r, v, decay, a = hs(r), hs(v), hs(decay), hs(a)

    def step(state, inp):
        r_t, w_t, k_t, v_t, kk_t, a_t = inp
        sa = jnp.einsum('bhij,bhj->bhi', state, -kk_t)
        state = (state * w_t[:, :, None, :]
                 + sa[..., None] * (kk_t * a_t)[:, :, None, :]
                 + v_t[..., None] * k_t[:, :, None, :])
        return state, jnp.einsum('bhij,bhj->bhi', state, r_t)

    xs = tuple(jnp.moveaxis(t, 1, 0) for t in (r, decay, k, v, kk, a))
    state0 = jnp.zeros((b, N_HEADS, HEAD_DIM, HEAD_DIM), jnp.float32)
    _, y = lax.scan(step, state0, xs)
    y = jnp.moveaxis(y, 0, 1)
    mean = jnp.mean(y, axis=-1, keepdims=True)
    var = jnp.mean(jnp.square(y - mean), axis=-1, keepdims=True)
    y = ((y - mean) * lax.rsqrt(var + GN_EPS)).reshape(b, s, G) * ln_g + ln_b
    bonus = jnp.sum(r * k * r_k, axis=-1, keepdims=True) * v
    return y + bonus.reshape(b, s, G)


def rg_lru(x, conv_w, conv_b, w_a, b_a, w_x, b_x, lam):
    x = x.astype(jnp.float32)
    b, s, c = x.shape
    xc = lax.conv_general_dilated(
        x, conv_w.astype(jnp.float32)[:, None, :], window_strides=(1,),
        padding=[(CONV_WIDTH - 1, 0)], dimension_numbers=('NWC', 'WIO', 'NWC'),
        feature_group_count=c) + conv_b
    xh = xc.reshape(b, s, N_HEADS, HEAD_DIM)
    r = jax.nn.sigmoid(jnp.einsum('bsni,nij->bsnj', xh, w_a).reshape(b, s, c) + b_a)
    i = jax.nn.sigmoid(jnp.einsum('bsni,nij->bsnj', xh, w_x).reshape(b, s, c) + b_x)
    log_a = -LRU_C * r * jax.nn.softplus(-lam)
    a = jnp.exp(log_a)
    u = jnp.sqrt(-jnp.expm1(2.0 * log_a)) * (i * xc)

    def combine(lhs, rhs):
        a1, b1 = lhs
        a2, b2 = rhs
        return a1 * a2, a2 * b1 + b2

    _, h = lax.associative_scan(combine, (a, u), axis=1)
    return h


def setup_inputs(seed: int = 0) -> dict:
    key = jax.random.key(seed)
    ks = jax.random.split(key, 24)
    f32 = jnp.float32
    L, D, G, H, R, N = DEPTH, D_MODEL, D_GROUP, N_HEADS, RWKV_LORA, HEAD_DIM

    def nrm(k, shape, scale):
        return scale * jax.random.normal(k, shape, f32)

    x = jax.random.normal(ks[0], (BATCH, SEQ, D), f32)
    norm_g = 1.0 + nrm(ks[1], (L, D), 0.05)
    w_in = nrm(ks[2], (L, D, N_IN), D ** -0.5)
    b_forget = 2.0 + nrm(ks[3], (L, H), 0.5)
    rwkv_mu = jax.random.uniform(ks[4], (L, N_RWKV_SHIFT), f32)
    rwkv_w0 = jax.random.uniform(ks[5], (L, G), f32, -6.0, 0.0)
    rwkv_w2 = nrm(ks[6], (L, R, G), 0.1 * R ** -0.5)
    rwkv_a0 = nrm(ks[7], (L, G), 0.1)
    rwkv_a2 = nrm(ks[8], (L, R, G), 0.1 * R ** -0.5)
    rwkv_k_k = 0.85 + nrm(ks[9], (L, G), 0.05)
    rwkv_k_a = 1.0 + nrm(ks[10], (L, G), 0.05)
    rwkv_r_k = nrm(ks[11], (L, H, N), 0.1)
    rwkv_ln_g = 1.0 + nrm(ks[12], (L, G), 0.05)
    rwkv_ln_b = nrm(ks[13], (L, G), 0.02)
    lru_conv_w = nrm(ks[14], (L, CONV_WIDTH, G), CONV_WIDTH ** -0.5)
    lru_conv_b = nrm(ks[15], (L, G), 0.02)
    lru_w_a = nrm(ks[16], (L, H, N, N), N ** -0.5)
    lru_b_a = nrm(ks[17], (L, G), 0.02)
    lru_w_x = nrm(ks[18], (L, H, N, N), N ** -0.5)
    lru_b_x = nrm(ks[19], (L, G), 0.02)
    a_pow_c = jax.random.uniform(ks[20], (L, G), f32, 0.9, 0.999)
    a_base = a_pow_c ** (1.0 / LRU_C)
    lru_lambda = jnp.log(a_base) - jnp.log1p(-a_base)
    w_out = nrm(ks[21], (L, D_MIX, D), D_MIX ** -0.5)
    final_g = 1.0 + nrm(ks[22], (D,), 0.05)
    return {"x": x, "norm_g": norm_g, "w_in": w_in, "b_forget": b_forget,
            "rwkv_mu": rwkv_mu, "rwkv_w0": rwkv_w0, "rwkv_w2": rwkv_w2,
            "rwkv_a0": rwkv_a0, "rwkv_a2": rwkv_a2, "rwkv_k_k": rwkv_k_k,
            "rwkv_k_a": rwkv_k_a, "rwkv_r_k": rwkv_r_k, "rwkv_ln_g": rwkv_ln_g,
            "rwkv_ln_b": rwkv_ln_b, "lru_conv_w": lru_conv_w, "lru_conv_b": lru_conv_b,
            "lru_w_a": lru_w_a, "lru_b_a": lru_b_a, "lru_w_x": lru_w_x,
            "lru_b_x": lru_b_x, "lru_lambda": lru_lambda, "w_out": w_out,
            "final_g": final_g}


def reference(x, norm_g, w_in, b_forget, rwkv_mu, rwkv_w0, rwkv_w2, rwkv_a0, rwkv_a2,
              rwkv_k_k, rwkv_k_a, rwkv_r_k, rwkv_ln_g, rwkv_ln_b, lru_conv_w, lru_conv_b,
              lru_w_a, lru_b_a, lru_w_x, lru_b_x, lru_lambda, w_out, final_g):
    f32 = jnp.float32
    for l in range(DEPTH):
        h = rms_norm(x, norm_g[l])
        p = h @ w_in[l]
        (fq, fk, fv, fg, ff, sq, sk, sv, sg, rw, rg, lx, lg) = split_columns(p)
        log_f = jax.nn.log_sigmoid(ff.astype(f32) + b_forget[l]).transpose(0, 2, 1)
        y_fox = forgetting_attention(to_heads(fq), to_heads(fk), to_heads(fv), log_f)
        y_sb = stick_breaking_attention(to_heads(sq), to_heads(sk), to_heads(sv))
        y_rw = rwkv7_time_mix(rw, rwkv_mu[l], rwkv_w0[l], rwkv_w2[l], rwkv_a0[l], rwkv_a2[l],
                              rwkv_k_k[l], rwkv_k_a[l], rwkv_r_k[l], rwkv_ln_g[l], rwkv_ln_b[l])
        y_lru = rg_lru(lx, lru_conv_w[l], lru_conv_b[l], lru_w_a[l], lru_b_a[l],
                       lru_w_x[l], lru_b_x[l], lru_lambda[l])
        y = jnp.concatenate([
            y_fox * jax.nn.silu(fg.astype(f32)),
            y_sb * jax.nn.silu(sg.astype(f32)),
            y_rw * jax.nn.silu(rg.astype(f32)),
            y_lru * jax.nn.silu(lg.astype(f32)),
        ], axis=-1).astype(x.dtype)
        x = x + y @ w_out[l]
    return rms_norm(x, final_g)
```

```cpp
#include <hip/hip_runtime.h>
#include <hip/hip_cooperative_groups.h>
#include <cstdio>
#include <cstdint>
namespace cg = cooperative_groups;
namespace pg8 {
#define PG8_LAS __attribute__((address_space(3)))
typedef unsigned short bf16_t;
typedef short bf16x8 __attribute__((ext_vector_type(8)));
typedef float f32x4 __attribute__((ext_vector_type(4)));
typedef unsigned u32x4 __attribute__((ext_vector_type(4)));
constexpr int BM = 256, BK = 64, HALF = 128, HTB = HALF * BK * 2  , STAGE_BYTES = 8 * HTB, NXCD = 8, WGM = 8;

__host__ __device__ __forceinline__ int lds_byte(int r, int c) { const int st = (r >> 4) * 2 + (c >> 5), rr = r & 15, cc = c & 31, ob = rr * 64 + cc * 2; return st * 1024 + (ob ^ (((ob >> 9) & 1) << 5)); }
__host__ __device__ __forceinline__ void stage_rc(int b, int& R, int& C) { const int st = b / 1024, sb = b % 1024, swz = sb ^ (((sb >> 9) & 1) << 5); R = (st >> 1) * 16 + swz / 64; C = (st & 1) * 32 + (swz % 64) / 2; }
__host__ __device__ __forceinline__ int perm32(int rho) { const int n = rho >> 4, i = rho & 15; return 8 * (i >> 2) + 4 * n + (i & 3); }

struct Unit { int pm, pn; };
struct Gemm { const bf16_t* A; const bf16_t* Bt; int M, N, K; };

struct StaticOrder {
    int nM, nN, nwg, G, c;
    __host__ __device__ void init(int M, int N, int G_, int c_) { nM = M / BM; nN = N / BM; nwg = nM * nN; G = G_; c = c_; }
    __host__ __device__ bool next(int i, Unit& u) const {
        const long L = (long)i * G + c; if (L >= nwg) return false;
        int wgid = (int)L; { const int q = nwg / NXCD, r = nwg % NXCD, xcd = wgid % NXCD, off = wgid / NXCD; wgid = (xcd < r ? xcd * (q + 1) : r * (q + 1) + (xcd - r) * q) + off; }
        const int nig = WGM * nN, gid = wgid / nig, fm = gid * WGM, gsz = (nM - fm) < WGM ? (nM - fm) : WGM;
        u.pm = fm + ((wgid % nig) % gsz); u.pn = (wgid % nig) / gsz; return true;
    }
    __device__ __forceinline__ void a_ready(const Unit&) const {}
    __device__ __forceinline__ void done(const Unit&) const {}
};

__device__ __forceinline__ unsigned cvt_pk_bf16(float lo, float hi) { unsigned r; asm volatile("v_cvt_pk_bf16_f32 %0, %1, %2" : "=v"(r) : "v"(lo), "v"(hi)); return r; }

template <class Epi, class Sched, bool ALIGN_EPI = false, bool SP2 = false>
__device__ __forceinline__ void gemm_phase(PG8_LAS unsigned char* lds, const Gemm g, const Sched& S, const Epi& E) {
    int tid_ = threadIdx.x; asm volatile("" : "+v"(tid_)); const int tid = tid_, wid = __builtin_amdgcn_readfirstlane(tid >> 6), lane = tid & 63, wr = wid >> 2, wc = wid & 3, fr = lane & 15, fq = lane >> 4;
    const int K = g.K, nt = K / BK;
    unsigned voffA[2], voffB[2];
#pragma unroll
    for (int i = 0; i < 2; ++i) { int R, C; stage_rc(tid * 16 + i * 8192, R, C); const int Rb = Epi::PERM ? ((R & ~31) + perm32(R & 31)) : R;
        voffA[i] = (unsigned)(R * K + C) * 2u; voffB[i] = (unsigned)(Rb * K + C) * 2u; }
    const size_t kstep = (size_t)(BK * 2);
    const size_t hstep = (size_t)HALF * K * 2;
    const size_t tstep = 2 * hstep;
    const unsigned ldsw = (unsigned)wid * 1024u;
    const int aoff = lds_byte(wr * 64 + fr, fq * 8), boff = lds_byte(wc * 32 + fr, fq * 8);
#define PG8_SA(b, h) (((b) * 2 + (h)) * HTB)
#define PG8_SB(b, h) ((4 + (b) * 2 + (h)) * HTB)
#define PG8_STAGE(bufoff, gbase, voff) do { _Pragma("unroll") for (int _i = 0; _i < 2; ++_i) \
        __builtin_amdgcn_global_load_lds((const unsigned*)((const char*)(gbase) + (voff)[_i]), (PG8_LAS unsigned*)(lds + (bufoff) + ldsw + _i * 8192), 16, 0, 0); } while (0)
#define PG8_LDA(dst, b, h) do { _Pragma("unroll") for (int m = 0; m < 4; ++m) _Pragma("unroll") for (int k = 0; k < 2; ++k) dst[m][k] = *(const PG8_LAS bf16x8*)(lds + PG8_SA(b, h) + aoff + m * 2048 + k * 1024); } while (0)
#define PG8_LDB(dst, b, h) do { _Pragma("unroll") for (int n = 0; n < 2; ++n) _Pragma("unroll") for (int k = 0; k < 2; ++k) dst[n][k] = *(const PG8_LAS bf16x8*)(lds + PG8_SB(b, h) + boff + n * 2048 + k * 1024); } while (0)
#define PG8_MMA(ai, bj, At, Bt) do { __builtin_amdgcn_s_setprio(1); _Pragma("unroll") for (int m = 0; m < 4; ++m) _Pragma("unroll") for (int n = 0; n < 2; ++n) _Pragma("unroll") for (int k = 0; k < 2; ++k) \
        acc[ai][bj][m][n] = __builtin_amdgcn_mfma_f32_16x16x32_bf16(Bt[n][k], At[m][k], acc[ai][bj][m][n], 0, 0, 0); __builtin_amdgcn_s_setprio(0); } while (0)
#define PG8_WAIT_V(n) asm volatile("s_waitcnt vmcnt(" #n ")" ::: "memory")
#define PG8_WAIT_L(n) asm volatile("s_waitcnt lgkmcnt(" #n ")" ::: "memory")
#define PG8_BAR __builtin_amdgcn_s_barrier()
#define PG8_SCHED __builtin_amdgcn_sched_barrier(0)
    Unit cur, nxt; int ui = 0;
    if (!S.next(0, cur)) return;
    f32x4 acc[2][2][4][2];
#pragma unroll
    for (int a = 0; a < 2; ++a)
#pragma unroll
        for (int b = 0; b < 2; ++b)
#pragma unroll
            for (int m = 0; m < 4; ++m)
#pragma unroll
                for (int n = 0; n < 2; ++n) acc[a][b][m][n] = (f32x4){0.f, 0.f, 0.f, 0.f};
    bf16x8 At[4][2], B0[2][2], B1[2][2];
    const char* cA = (const char*)g.A + (size_t)cur.pm * tstep; const char* cB = (const char*)g.Bt + (size_t)cur.pn * tstep;
    S.a_ready(cur);
    if constexpr (SP2) {
        PG8_STAGE(PG8_SB(0, 0), cB, voffB); PG8_STAGE(PG8_SB(0, 1), cB + hstep, voffB); PG8_STAGE(PG8_SA(0, 0), cA, voffA); PG8_STAGE(PG8_SA(0, 1), cA + hstep, voffA);
        if (wr == 1) PG8_BAR;
        PG8_WAIT_V(2); PG8_BAR;
        PG8_STAGE(PG8_SB(1, 0), cB + kstep, voffB); PG8_STAGE(PG8_SA(1, 0), cA + kstep, voffA); PG8_STAGE(PG8_SB(1, 1), cB + hstep + kstep, voffB);
        PG8_WAIT_V(6); PG8_BAR;
    } else {
        PG8_STAGE(PG8_SB(0, 0), cB, voffB); PG8_STAGE(PG8_SA(0, 0), cA, voffA); PG8_STAGE(PG8_SB(0, 1), cB + hstep, voffB); PG8_STAGE(PG8_SA(0, 1), cA + hstep, voffA);
        if (wr == 1) PG8_BAR;
        PG8_WAIT_V(4); PG8_BAR;
        PG8_STAGE(PG8_SB(1, 0), cB + kstep, voffB); PG8_STAGE(PG8_SA(1, 0), cA + kstep, voffA); PG8_STAGE(PG8_SB(1, 1), cB + hstep + kstep, voffB);
        PG8_WAIT_V(6); PG8_BAR;
    }
    for (;;) {
        const bool has_next = S.next(ui + 1, nxt);
        const char* nA = has_next ? (const char*)g.A + (size_t)nxt.pm * tstep : cA; const char* nB = has_next ? (const char*)g.Bt + (size_t)nxt.pn * tstep : cB;
        for (int t = 0; t < nt; t += 2) {
            const bool last = (t == nt - 2);
            const char* a1 = cA + (size_t)(t + 1) * kstep;
            const char* a2 = last ? nA : cA + (size_t)(t + 2) * kstep; const char* b2 = last ? nB : cB + (size_t)(t + 2) * kstep;
            const char* a3 = a2 + kstep; const char* b3 = b2 + kstep;
            if (last && has_next) S.a_ready(nxt);
            if constexpr (SP2) {
            PG8_LDB(B0, 0, 0); PG8_LDB(B1, 0, 1); PG8_SCHED; PG8_LDA(At, 0, 0); PG8_STAGE(PG8_SA(1, 1), a1 + hstep, voffA);
            PG8_WAIT_V(8); PG8_WAIT_L(0); PG8_BAR; PG8_MMA(0, 0, At, B0); PG8_MMA(0, 1, At, B1); PG8_BAR; PG8_SCHED;
            PG8_LDA(At, 0, 1); PG8_STAGE(PG8_SB(0, 0), b2, voffB); PG8_STAGE(PG8_SB(0, 1), b2 + hstep, voffB); PG8_STAGE(PG8_SA(0, 0), a2, voffA);
            PG8_WAIT_V(8); PG8_WAIT_L(0); PG8_BAR; PG8_MMA(1, 0, At, B0); PG8_MMA(1, 1, At, B1); PG8_BAR; PG8_SCHED;
            PG8_LDB(B0, 1, 0); PG8_LDB(B1, 1, 1); PG8_SCHED; PG8_LDA(At, 1, 0); PG8_STAGE(PG8_SA(0, 1), a2 + hstep, voffA);
            PG8_WAIT_V(8); PG8_WAIT_L(0); PG8_BAR; PG8_MMA(0, 0, At, B0); PG8_MMA(0, 1, At, B1); PG8_BAR; PG8_SCHED;
            PG8_LDA(At, 1, 1); PG8_STAGE(PG8_SB(1, 0), b3, voffB); PG8_STAGE(PG8_SB(1, 1), b3 + hstep, voffB); PG8_STAGE(PG8_SA(1, 0), a3, voffA);
            PG8_WAIT_V(8); PG8_WAIT_L(0); PG8_BAR; PG8_MMA(1, 0, At, B0); PG8_MMA(1, 1, At, B1); PG8_BAR; PG8_SCHED;
            } else {
            PG8_LDB(B0, 0, 0); PG8_SCHED; PG8_LDA(At, 0, 0); PG8_STAGE(PG8_SA(1, 1), a1 + hstep, voffA);
            PG8_WAIT_L(8); PG8_BAR; PG8_WAIT_L(0); PG8_MMA(0, 0, At, B0); PG8_BAR; PG8_SCHED;
            PG8_LDB(B1, 0, 1); PG8_STAGE(PG8_SB(0, 0), b2, voffB);
            PG8_BAR; PG8_WAIT_L(0); PG8_MMA(0, 1, At, B1); PG8_BAR;
            PG8_LDA(At, 0, 1); PG8_STAGE(PG8_SA(0, 0), a2, voffA);
            PG8_BAR; PG8_WAIT_L(0); PG8_MMA(1, 0, At, B0); PG8_BAR; PG8_SCHED;
            PG8_STAGE(PG8_SB(0, 1), b2 + hstep, voffB);
            PG8_WAIT_V(6); PG8_BAR; PG8_MMA(1, 1, At, B1); PG8_BAR;
            PG8_LDB(B0, 1, 0); PG8_SCHED; PG8_LDA(At, 1, 0); PG8_STAGE(PG8_SA(0, 1), a2 + hstep, voffA);
            PG8_WAIT_L(8); PG8_BAR; PG8_WAIT_L(0); PG8_MMA(0, 0, At, B0); PG8_BAR; PG8_SCHED;
            PG8_LDB(B1, 1, 1); PG8_STAGE(PG8_SB(1, 0), b3, voffB);
            PG8_BAR; PG8_WAIT_L(0); PG8_MMA(0, 1, At, B1); PG8_BAR;
            PG8_LDA(At, 1, 1); PG8_STAGE(PG8_SA(1, 0), a3, voffA);
            PG8_BAR; PG8_WAIT_L(0); PG8_MMA(1, 0, At, B0); PG8_BAR; PG8_SCHED;
            PG8_STAGE(PG8_SB(1, 1), b3 + hstep, voffB);
            PG8_WAIT_V(6); PG8_BAR; PG8_MMA(1, 1, At, B1); PG8_BAR;
            }
        }
        if constexpr (ALIGN_EPI) { if (wr == 0) PG8_BAR; }
        if constexpr (!Epi::AFTER_DRAIN) { E(acc, cur, wr, wc, fr, fq); S.done(cur); }
        if (!has_next) break;
#pragma unroll
        for (int a = 0; a < 2; ++a)
#pragma unroll
            for (int b = 0; b < 2; ++b)
#pragma unroll
                for (int m = 0; m < 4; ++m)
#pragma unroll
                    for (int n = 0; n < 2; ++n) acc[a][b][m][n] = (f32x4){0.f, 0.f, 0.f, 0.f};
        cur = nxt; cA = nA; cB = nB; ++ui;
        if constexpr (ALIGN_EPI) { if (wr == 1) PG8_BAR; }
    }
    PG8_WAIT_V(0);
    if constexpr (!ALIGN_EPI) { if (wr == 0) PG8_BAR; }
    PG8_BAR;
    if constexpr (Epi::AFTER_DRAIN) { E.fused(acc, cur, wr, wc, fr, fq, lds, wid, lane); S.done(cur); }
#undef PG8_SA
#undef PG8_SB
#undef PG8_STAGE
#undef PG8_LDA
#undef PG8_LDB
#undef PG8_MMA
#undef PG8_WAIT_V
#undef PG8_WAIT_L
#undef PG8_BAR
#undef PG8_SCHED
}
}

#define LAS __attribute__((address_space(3)))
#ifndef USE_CG_SYNC
#define USE_CG_SYNC 0
#endif
typedef unsigned short bf16_t;
typedef short bf16x8 __attribute__((ext_vector_type(8)));
typedef float f32x4 __attribute__((ext_vector_type(4)));
typedef float f32x16 __attribute__((ext_vector_type(16)));
typedef unsigned u32x4 __attribute__((ext_vector_type(4)));
typedef unsigned u32x2 __attribute__((ext_vector_type(2)));
typedef float f32x2_t __attribute__((ext_vector_type(2)));
typedef __bf16 bf16x2_t __attribute__((ext_vector_type(2)));

constexpr int BATCH = 2, SEQ = 8192, DM = 1024, M = BATCH * SEQ, NHEAD = 4, DEPTH = 2;
constexpr int NIN = 3652, NP = 3840;
constexpr int T_FQ = 0, T_SQ = 4, T_RR = 8, T_RK = 9, T_RV = 10, T_RG = 11, T_LX = 12, T_LG = 13, T_MISC = 14;
constexpr float LOG2E = 1.4426950408889634f;
constexpr float C2 = 0.125f * LOG2E;
constexpr int LDS_BYTES = 147456;
constexpr int NTHR = 512;

constexpr size_t MiB = 1u << 20;
constexpr size_t WS_CTL = 0, WS_ROWSS = 64 * 1024, WS_FL = 256 * 1024, WS_BAR = 16 * 1024, WS_FTOT = 512 * 1024, WS_KMAX = 640 * 1024, WS_HIN = 704 * 1024, WS_LORA = 960 * 1024;
constexpr size_t WS_WIN = 1 * MiB, WS_WOUT = 16 * MiB, WS_XB = 20 * MiB, WS_Y = 52 * MiB, WS_P = 84 * MiB, WS_LH = 204 * MiB, WS_LA = 220 * MiB, WS_END = 253 * MiB;

struct Args { const float* in[23]; float* out; unsigned char* ws; };
typedef const __attribute__((address_space(4))) Args KArgs;
#define ARGP() ({ KArgs* p_ = (KArgs*)__builtin_amdgcn_kernarg_segment_ptr(); asm volatile("" : "+s"(p_)); p_; })

__device__ __forceinline__ float bf2f(bf16_t v) { return __builtin_bit_cast(float, (unsigned)v << 16); }
__device__ __forceinline__ float bflo(unsigned v) { return __builtin_bit_cast(float, v << 16); }
__device__ __forceinline__ float bfhi(unsigned v) { return __builtin_bit_cast(float, v & 0xffff0000u); }
__device__ __forceinline__ unsigned cvtpk(float lo, float hi) { f32x2_t v = {lo, hi}; bf16x2_t b = __builtin_convertvector(v, bf16x2_t); return __builtin_bit_cast(unsigned, b); }
__device__ __forceinline__ float wave_sum(float v) {
#pragma unroll
    for (int o = 1; o < 64; o <<= 1) v += __shfl_xor(v, o);
    return v;
}
__device__ __forceinline__ float sigm(float x) { return __builtin_amdgcn_rcpf(1.f + __expf(-x)); }
__device__ __forceinline__ float softplus_(float x) { return fmaxf(x, 0.f) + __logf(1.f + __expf(-fabsf(x))); }
__device__ __forceinline__ float tanh_(float x) { const float e = __expf(-2.f * fabsf(x)); const float t = (1.f - e) * __builtin_amdgcn_rcpf(1.f + e); return x < 0.f ? -t : t; }
__device__ __forceinline__ float ex2(float x) { return __builtin_amdgcn_exp2f(x); }
template <int CTRL> __device__ __forceinline__ float dpp_f(float x) { return __builtin_bit_cast(float, __builtin_amdgcn_update_dpp(0, __builtin_bit_cast(int, x), CTRL, 0xf, 0xf, true)); }
__device__ __forceinline__ float red8(float x) { x += dpp_f<0xB1>(x); x += dpp_f<0x4E>(x); x += dpp_f<0x141>(x); return x; }
__device__ __forceinline__ int tid_fresh() { int t = threadIdx.x; asm volatile("" : "+v"(t)); return t; }
#define LDS_WAIT() asm volatile("s_waitcnt lgkmcnt(0)" ::: "memory")
#define BAR_LDS() asm volatile("s_waitcnt lgkmcnt(0)\n\ts_barrier" ::: "memory")

__device__ __forceinline__ int orig_col(int n) {
    const int t = n >> 8, c = n & 255;
    if (t < 4) return n;
    if (t < 8) return 1028 + (t - 4) * 256 + c;
    if (t < 11) return 2052 + (t - 8) * 256 + c;
    if (t < 14) return 2884 + (t - 11) * 256 + c;
    if (c < 64) return 2820 + c;
    if (c < 68) return 1024 + (c - 64);
    return -1;
}

struct EpiIn {
    static constexpr bool PERM = true, AFTER_DRAIN = false;
    bf16_t* P; const float* rowss;
    __device__ __forceinline__ void operator()(const pg8::f32x4 (&acc)[2][2][4][2], const pg8::Unit& u, int wr, int wc, int fr, int fq) const {
        const int row0 = u.pm * 256 + wr * 64 + fr, col0 = u.pn * 256 + wc * 32 + 8 * fq;
        float rsv[8];
#pragma unroll
        for (int i = 0; i < 8; ++i) rsv[i] = rowss[row0 + (i >> 2) * 128 + (i & 3) * 16];
#pragma unroll
        for (int ai = 0; ai < 2; ++ai)
#pragma unroll
            for (int m = 0; m < 4; ++m) {
                const int row = row0 + ai * 128 + m * 16;
                const float rs = rsqrtf(rsv[ai * 4 + m] * (1.f / 1024.f) + 1e-6f);
                bf16_t* rp = P + (size_t)row * NP + col0;
#pragma unroll
                for (int bj = 0; bj < 2; ++bj) {
                    const f32x4 v0 = acc[ai][bj][m][0] * rs, v1 = acc[ai][bj][m][1] * rs;
                    u32x4 w; w.x = cvtpk(v0[0], v0[1]); w.y = cvtpk(v0[2], v0[3]); w.z = cvtpk(v1[0], v1[1]); w.w = cvtpk(v1[2], v1[3]);
                    *(u32x4*)(rp + bj * 128) = w;
                }
            }
    }
};
__device__ __forceinline__ float partner32(float x, bool upper) {
    const unsigned u = __builtin_bit_cast(unsigned, x);
    auto rr = __builtin_amdgcn_permlane32_swap(u, u, false, false);
    return __builtin_bit_cast(float, (unsigned)(upper ? rr[0] : rr[1]));
}
struct EpiOut {
    static constexpr bool PERM = true, AFTER_DRAIN = false;
    const float* xin; float* xout; bf16_t* xb; float* rss;
    __device__ __forceinline__ void operator()(const pg8::f32x4 (&acc)[2][2][4][2], const pg8::Unit& u, int wr, int wc, int fr, int fq) const {
        const int row0 = u.pm * 256 + wr * 64 + fr, cg = u.pn * 256 + wc * 32, col0 = cg + 8 * fq;
        const bool up = fq >= 2;
        const int pcA = up ? 2 * (fq - 2) + 1 : 2 * fq, pcB = up ? 2 * fq : 2 * (fq + 2) + 1;
#pragma unroll
        for (int am = 0; am < 8; ++am) {
            const int ai = am >> 2, m = am & 3;
            const int row = row0 + ai * 128 + m * 16;
            f32x4 lA[2], lB[2];
#pragma unroll
            for (int bj = 0; bj < 2; ++bj) { const size_t gb = (size_t)row * DM + cg + bj * 128; lA[bj] = *(const f32x4*)(xin + gb + 4 * pcA); lB[bj] = *(const f32x4*)(xin + gb + 4 * pcB); }
            float ss = 0.f;
#pragma unroll
            for (int bj = 0; bj < 2; ++bj) {
                const size_t gb = (size_t)row * DM + cg + bj * 128;
                const f32x4 x0 = up ? lB[bj] : lA[bj], tp = up ? lA[bj] : lB[bj];
                f32x4 x1;
#pragma unroll
                for (int e = 0; e < 4; ++e) x1[e] = partner32(tp[e], up);
                const f32x4 v0 = acc[ai][bj][m][0] + x0, v1 = acc[ai][bj][m][1] + x1;
                if (xout) {
                    f32x4 pv1;
#pragma unroll
                    for (int e = 0; e < 4; ++e) pv1[e] = partner32(v1[e], up);
                    *(f32x4*)(xout + gb + 4 * pcA) = up ? pv1 : v0;
                    *(f32x4*)(xout + gb + 4 * pcB) = up ? v0 : pv1;
                }
                u32x4 w; w.x = cvtpk(v0[0], v0[1]); w.y = cvtpk(v0[2], v0[3]); w.z = cvtpk(v1[0], v1[1]); w.w = cvtpk(v1[2], v1[3]);
                *(u32x4*)(xb + (size_t)row * DM + col0 + bj * 128) = w;
                ss += (v0[0] * v0[0] + v0[1] * v0[1]) + (v0[2] * v0[2] + v0[3] * v0[3]) + (v1[0] * v1[0] + v1[1] * v1[1]) + (v1[2] * v1[2] + v1[3] * v1[3]);
            }
            ss += __shfl_xor(ss, 16); ss += __shfl_xor(ss, 32); if (fq == 0) atomicAdd(rss + row, ss);
        }
    }
};

__device__ __forceinline__ void tr_item(const float* W, int ldw, const float* gk, bool permute, bf16_t* WT, int K, LAS float* scr, int kb, int nb, int lane) {
    const int k0 = 64 * kb, n0 = 32 * nb;
    const int n = n0 + (lane & 31);
    const int oc = permute ? orig_col(n) : n;
#pragma unroll
    for (int i = 0; i < 32; ++i) {
        const int kk = 2 * i + (lane >> 5);
        float v = (oc >= 0) ? W[(size_t)(k0 + kk) * ldw + oc] : 0.f;
        if (gk) v *= gk[k0 + kk];
        scr[kk * 33 + (lane & 31)] = v;
    }
    LDS_WAIT();
    const int c = lane & 7;
#pragma unroll
    for (int j = 0; j < 4; ++j) {
        const int nn = (lane >> 3) + 8 * j; const LAS float* s = scr + (8 * c) * 33 + nn;
        u32x4 o; o.x = cvtpk(s[0 * 33], s[1 * 33]); o.y = cvtpk(s[2 * 33], s[3 * 33]); o.z = cvtpk(s[4 * 33], s[5 * 33]); o.w = cvtpk(s[6 * 33], s[7 * 33]);
        *(u32x4*)(WT + (size_t)(n0 + nn) * K + k0 + 8 * c) = o;
    }
    LDS_WAIT();
}

typedef short s16x4_t __attribute__((ext_vector_type(4)));
__device__ __forceinline__ s16x4_t vtr16(const LAS unsigned char* p) { return __builtin_amdgcn_ds_read_tr16_b64_v4i16((LAS s16x4_t*)p); }
__device__ __forceinline__ int kpos(int key) { return (key & 48) | ((key & 4) << 1) | ((key & 8) >> 1) | (key & 3); }
__device__ __forceinline__ bf16x8 pack8(float a, float b, float c, float d, float e, float f, float g, float h) {
    u32x4 w; w.x = cvtpk(a, b); w.y = cvtpk(c, d); w.z = cvtpk(e, f); w.w = cvtpk(g, h); return __builtin_bit_cast(bf16x8, w);
}

template <int MODE>
__device__ __forceinline__ void attn_unit(LAS unsigned char* lds, const bf16_t* P, bf16_t* Y, const float* Fl, const float* Ftot, const float* Kc, int bh, int qb) {
    constexpr int QT = (MODE == 0) ? T_FQ : T_SQ, KT = QT + 1, VT = QT + 2, GT = QT + 3;
    constexpr int KP = 144, KBUF = 64 * KP;
    constexpr int O_K = 0, O_V = 2 * KBUF, O_F = 4 * KBUF, O_FOFF = O_F + 512;
    const int tid = tid_fresh(), lane = tid & 63, r32 = lane & 31, hi = lane >> 5;
    const int wid = __builtin_amdgcn_readfirstlane(tid >> 6);
    const int b = bh >> 2, h = bh & 3;
    const size_t rowbase = (size_t)b * SEQ;
    const int qw0 = qb * 256 + wid * 32;
    const int qg = qw0 + r32;
    LAS float* foff = (LAS float*)(lds + O_FOFF);
    LAS float* Lkpm = (LAS float*)(lds + O_FOFF + 128);
    LAS int* Lalive = (LAS int*)(lds + O_FOFF + 256);
    bf16x8 qr[4];
    {
        const bf16_t* qp = P + (rowbase + qg) * NP + QT * 256 + h * 64 + hi * 8;
#pragma unroll
        for (int st = 0; st < 4; ++st) qr[st] = *(const bf16x8*)(qp + st * 16);
    }
    float Fq = 0.f, qnC = 0.f;
    if (MODE == 0) {
        Fq = Fl[(size_t)bh * SEQ + qg];
        float q2 = 0.f;
#pragma unroll
        for (int st = 0; st < 4; ++st)
#pragma unroll
            for (int e = 0; e < 8; ++e) { const float qv = bf2f((bf16_t)qr[st][e]); q2 += qv * qv; }
        q2 += __shfl_xor(q2, 32);
        qnC = sqrtf(q2) * C2;
    }
    bool done = false;
    const int skey = tid >> 3, sch = tid & 7;
    const bf16_t* kg = P + (rowbase + skey) * NP + KT * 256 + h * 64 + sch * 8;
    const bf16_t* vg = P + (rowbase + skey) * NP + VT * 256 + h * 64 + sch * 8;
    const float* fg = Fl + (size_t)bh * SEQ + (tid & 63);
    const int kwoff = O_K + skey * KP + sch * 16;
    const int vwoff = O_V + skey * KP + sch * 16;
    u32x4 kA, vA, kB, vB; float fA = 0.f, fB = 0.f;
#define LOAD_TILE(KS, VS, FS, jj) do { KS = *(const u32x4*)(kg + (size_t)(jj) * 64 * NP); VS = *(const u32x4*)(vg + (size_t)(jj) * 64 * NP); if (MODE == 0 && tid < 64) FS = fg[(jj) * 64]; } while (0)
#define STORE_TILE(KS, VS, FS, bufi) do { *(LAS u32x4*)(lds + (bufi) * KBUF + kwoff) = KS; \
        *(LAS u32x4*)(lds + (bufi) * KBUF + vwoff) = VS; \
        if (MODE == 0 && tid < 64) ((LAS float*)(lds + O_F + (bufi) * 256))[tid] = FS; } while (0)
    float m_run = -INFINITY, l_run = 0.f, R = 1.f;
    f32x16 o0, o1;
#pragma unroll
    for (int r = 0; r < 16; ++r) { o0[r] = 0.f; o1[r] = 0.f; }
    const int jd = 4 * qb + 3;
    u32x4 kC, vC; float fC = 0.f;
    LOAD_TILE(kC, vC, fC, jd); LOAD_TILE(kA, vA, fA, jd - 1); LOAD_TILE(kB, vB, fB, jd - 2);
    if (MODE == 0) {
        if (wid == 0) {
            const float ft = (lane < 32) ? Ftot[bh * 32 + lane] : 0.f;
            float inc = ft, km = (lane < 32) ? Kc[bh * 32 + lane] : 0.f;
#pragma unroll
            for (int o = 1; o < 32; o <<= 1) { const float n1 = __shfl_up(inc, o), n2 = __shfl_up(km, o); if (lane >= o) { inc += n1; km = fmaxf(km, n2); } }
            const float excl = inc - ft;
            const float offq = __shfl(excl, qb);
            if (lane < 32) { foff[lane] = excl - offq; Lkpm[lane] = sqrtf(km); }
        }
    }
    STORE_TILE(kC, vC, fC, 0);
    BAR_LDS();
#define ATT_ITER(KS, VS, FS) do { \
        const int buf = it & 1; \
        if (j >= 1) { STORE_TILE(KS, VS, FS, buf ^ 1); if (j >= 3) LOAD_TILE(KS, VS, FS, j - 3); } \
        bool walive = true; \
        if (64 * j <= qw0 + 31 && !done) { \
            const LAS unsigned char* kb = lds + O_K + buf * KBUF + r32 * KP + hi * 16; \
            f32x16 p0, p1; \
        _Pragma("unroll") \
            for (int r = 0; r < 16; ++r) { p0[r] = 0.f; p1[r] = 0.f; } \
        _Pragma("unroll") \
            for (int st = 0; st < 4; ++st) { \
                const bf16x8 a0 = *(const LAS bf16x8*)(kb + st * 32); \
                const bf16x8 a1 = *(const LAS bf16x8*)(kb + 32 * KP + st * 32); \
                p0 = __builtin_amdgcn_mfma_f32_32x32x16_bf16(a0, qr[st], p0, 0, 0, 0); \
                p1 = __builtin_amdgcn_mfma_f32_32x32x16_bf16(a1, qr[st], p1, 0, 0, 0); \
            } \
            if (MODE == 0) { \
                const LAS float* fs = (const LAS float*)(lds + O_F + buf * 256); \
                const float fq = Fq - foff[j >> 2]; \
                const bool band = (64 * j + 63 > qw0); \
                float mx = -INFINITY; \
        _Pragma("unroll") \
                for (int g = 0; g < 4; ++g) { \
                    const f32x4 f0 = *(const LAS f32x4*)(fs + 8 * g + 4 * hi); \
                    const f32x4 f1 = *(const LAS f32x4*)(fs + 32 + 8 * g + 4 * hi); \
        _Pragma("unroll") \
                    for (int e = 0; e < 4; ++e) { \
                        const int r = 4 * g + e; \
                        float z0 = p0[r] * C2 + (fq - f0[e]); \
                        float z1 = p1[r] * C2 + (fq - f1[e]); \
                        if (band) { const int k0 = 64 * j + 8 * g + 4 * hi + e; if (k0 > qg) z0 = -INFINITY; if (k0 + 32 > qg) z1 = -INFINITY; } \
                        p0[r] = z0; p1[r] = z1; mx = fmaxf(mx, fmaxf(z0, z1)); \
                    } \
                } \
                mx = fmaxf(mx, __shfl_xor(mx, 32)); \
                const float m_new = fmaxf(m_run, mx); \
                const float ms = (m_new == -INFINITY) ? 0.f : m_new; \
                const float alpha = ex2(m_run - ms); \
                float ls = 0.f; \
        _Pragma("unroll") \
                for (int r = 0; r < 16; ++r) { p0[r] = ex2(p0[r] - ms); p1[r] = ex2(p1[r] - ms); ls += p0[r] + p1[r]; } \
                l_run = l_run * alpha + ls; m_run = m_new; \
        _Pragma("unroll") \
                for (int r = 0; r < 16; ++r) { o0[r] *= alpha; o1[r] *= alpha; } \
                const float bound = qnC * Lkpm[(j > 0) ? ((j - 1) >> 2) : 0] + (fq - fs[0]); \
                walive = __builtin_amdgcn_ballot_w64(!(bound < m_run - 30.f)) != 0ull; \
            } else { \
                const bool band = (64 * j + 63 >= qw0); \
                f32x16 k0v, k1v; \
        _Pragma("unroll") \
                for (int r = 0; r < 16; ++r) { \
                    const float e0 = ex2(p0[r] * C2), e1 = ex2(p1[r] * C2); \
                    float kk0 = __builtin_amdgcn_rcpf(1.f + e0), kk1 = __builtin_amdgcn_rcpf(1.f + e1); \
                    float b0 = 1.f - kk0, b1 = 1.f - kk1; \
                    if (band) { const int key = 64 * j + (r & 3) + 8 * (r >> 2) + 4 * hi; if (key >= qg) { kk0 = 1.f; b0 = 0.f; } if (key + 32 >= qg) { kk1 = 1.f; b1 = 0.f; } } \
                    k0v[r] = kk0; k1v[r] = kk1; p0[r] = b0; p1[r] = b1; \
                } \
                float gp[8], og[8], E[8]; \
        _Pragma("unroll") \
                for (int k = 0; k < 4; ++k) { \
                    gp[k] = (k0v[4 * k] * k0v[4 * k + 1]) * (k0v[4 * k + 2] * k0v[4 * k + 3]); \
                    gp[4 + k] = (k1v[4 * k] * k1v[4 * k + 1]) * (k1v[4 * k + 2] * k1v[4 * k + 3]); \
                } \
        _Pragma("unroll") \
                for (int k = 0; k < 8; ++k) og[k] = __shfl_xor(gp[k], 32); \
                float SP = 1.f; \
        _Pragma("unroll") \
                for (int k = 7; k >= 0; --k) { E[k] = SP * (hi == 0 ? og[k] : 1.f); SP *= gp[k] * og[k]; } \
        _Pragma("unroll") \
                for (int k = 0; k < 4; ++k) { \
                    float w = R * E[k]; \
                    p0[4 * k + 3] *= w; w *= k0v[4 * k + 3]; p0[4 * k + 2] *= w; w *= k0v[4 * k + 2]; p0[4 * k + 1] *= w; w *= k0v[4 * k + 1]; p0[4 * k] *= w; \
                    float w1 = R * E[4 + k]; \
                    p1[4 * k + 3] *= w1; w1 *= k1v[4 * k + 3]; p1[4 * k + 2] *= w1; w1 *= k1v[4 * k + 2]; p1[4 * k + 1] *= w1; w1 *= k1v[4 * k + 1]; p1[4 * k] *= w1; \
                } \
                R *= SP; \
                walive = __builtin_amdgcn_ballot_w64(R > 1e-9f) != 0ull; \
            } \
            bf16x8 pa[4]; \
            pa[0] = pack8(p0[0], p0[1], p0[2], p0[3], p0[4], p0[5], p0[6], p0[7]); \
            pa[1] = pack8(p0[8], p0[9], p0[10], p0[11], p0[12], p0[13], p0[14], p0[15]); \
            pa[2] = pack8(p1[0], p1[1], p1[2], p1[3], p1[4], p1[5], p1[6], p1[7]); \
            pa[3] = pack8(p1[8], p1[9], p1[10], p1[11], p1[12], p1[13], p1[14], p1[15]); \
            const LAS unsigned char* vb = lds + O_V + buf * KBUF + (4 * hi + ((lane & 15) >> 2)) * KP + (16 * ((lane >> 4) & 1) + 4 * (lane & 3)) * 2; \
        _Pragma("unroll") \
            for (int ks = 0; ks < 4; ++ks) { \
                const s16x4_t l0_ = vtr16(vb + ks * 16 * KP), h0_ = vtr16(vb + ks * 16 * KP + 8 * KP); \
                const s16x4_t l1_ = vtr16(vb + ks * 16 * KP + 64), h1_ = vtr16(vb + ks * 16 * KP + 8 * KP + 64); \
                const bf16x8 v0 = {l0_[0], l0_[1], l0_[2], l0_[3], h0_[0], h0_[1], h0_[2], h0_[3]}; \
                const bf16x8 v1 = {l1_[0], l1_[1], l1_[2], l1_[3], h1_[0], h1_[1], h1_[2], h1_[3]}; \
                o0 = __builtin_amdgcn_mfma_f32_32x32x16_bf16(v0, pa[ks], o0, 0, 0, 0); \
                o1 = __builtin_amdgcn_mfma_f32_32x32x16_bf16(v1, pa[ks], o1, 0, 0, 0); \
            } \
            if (!walive) done = true; \
        } \
        if (done) walive = false; \
        if (lane == 0) Lalive[(it & 1) * 8 + wid] = walive ? 1 : 0; \
        BAR_LDS(); \
        { \
            const LAS int* av = Lalive + (it & 1) * 8; \
            const int any = (av[0] | av[1]) | (av[2] | av[3]) | (av[4] | av[5]) | (av[6] | av[7]); \
            if (!any) stop_ = true; \
        } \
    } while (0)
    {
        int j = jd, it = 0; bool stop_ = false;
        for (;;) {
            ATT_ITER(kA, vA, fA); --j; ++it; if (stop_ || j < 0) break;
            ATT_ITER(kB, vB, fB); --j; ++it; if (stop_ || j < 0) break;
        }
    }
#undef ATT_ITER
#undef LOAD_TILE
#undef STORE_TILE
    float inv = 1.f;
    if (MODE == 0) { const float lt = l_run + __shfl_xor(l_run, 32); inv = 1.f / lt; }
    const bf16_t* gpt = P + (rowbase + qg) * NP + GT * 256 + h * 64;
    LAS unsigned char* stg = lds + wid * 4608;
#pragma unroll
    for (int g = 0; g < 4; ++g) {
        const int d = 8 * g + 4 * hi;
        const u32x2 g0 = *(const u32x2*)(gpt + d), g1 = *(const u32x2*)(gpt + 32 + d);
        const float ga[4] = {bflo(g0.x), bfhi(g0.x), bflo(g0.y), bfhi(g0.y)};
        const float gb[4] = {bflo(g1.x), bfhi(g1.x), bflo(g1.y), bfhi(g1.y)};
        float ya[4], yb[4];
#pragma unroll
        for (int e = 0; e < 4; ++e) { ya[e] = o0[4 * g + e] * inv * ga[e] * sigm(ga[e]); yb[e] = o1[4 * g + e] * inv * gb[e] * sigm(gb[e]); }
        u32x2 wa, wb; wa.x = cvtpk(ya[0], ya[1]); wa.y = cvtpk(ya[2], ya[3]); wb.x = cvtpk(yb[0], yb[1]); wb.y = cvtpk(yb[2], yb[3]);
        *(LAS u32x2*)(stg + r32 * 144 + d * 2) = wa; *(LAS u32x2*)(stg + r32 * 144 + 64 + d * 2) = wb;
    }
    LDS_WAIT();
#pragma unroll
    for (int i = 0; i < 4; ++i) {
        const int row = 8 * i + (lane >> 3), ch = lane & 7;
        const u32x4 w = *(const LAS u32x4*)(stg + row * 144 + ch * 16);
        *(u32x4*)(Y + (rowbase + qw0 + row) * DM + (MODE ? 256 : 0) + h * 64 + ch * 8) = w;
    }
}

constexpr size_t WS_AG = WS_XB, WS_QG = WS_XB + 8 * MiB, WS_DG = WS_XB + 16 * MiB, WS_Y0 = 236 * MiB;
constexpr int L_CUM = 0, L_AF = 16384, L_MAB = 32768, L_AT = 49152, L_BT = 58368, L_KT = 67584, L_RT = 76800, L_VT = 86016, L_BH = 95232, L_KH = 104448,
              L_MAK = 113664, L_MRB = 122880, L_MRK = 132096, L_GC = 141312;
__device__ __forceinline__ int crow(int r, int hi) { return (r & 3) + 8 * (r >> 2) + 4 * hi; }
__device__ __forceinline__ float rowsum16(float x) { x += dpp_f<0xB1>(x); x += dpp_f<0x4E>(x); x += dpp_f<0x141>(x); x += dpp_f<0x140>(x); return x; }
__device__ __forceinline__ float wsum(float x) {
    x = rowsum16(x);
    const int xi = __builtin_bit_cast(int, x);
    return (__builtin_bit_cast(float, __builtin_amdgcn_readlane(xi, 0)) + __builtin_bit_cast(float, __builtin_amdgcn_readlane(xi, 16))) +
           (__builtin_bit_cast(float, __builtin_amdgcn_readlane(xi, 32)) + __builtin_bit_cast(float, __builtin_amdgcn_readlane(xi, 48)));
}
__device__ __forceinline__ f32x16 mm32(f32x16 acc, const LAS unsigned char* A, const LAS unsigned char* B, int tm, int tn, int r32, int hi) {
    const LAS unsigned char* ap = A + (32 * tm + r32) * 144 + hi * 16; const LAS unsigned char* bp = B + (32 * tn + r32) * 144 + hi * 16;
#pragma unroll
    for (int ks = 0; ks < 4; ++ks) acc = __builtin_amdgcn_mfma_f32_32x32x16_bf16(*(const LAS bf16x8*)(ap + ks * 32), *(const LAS bf16x8*)(bp + ks * 32), acc, 0, 0, 0);
    return acc;
}
__device__ __forceinline__ f32x4 mm16(f32x4 acc, const LAS unsigned char* A, int arow0, const LAS unsigned char* B, int brow0, int l15, int lq) {
    const LAS unsigned char* ap = A + (arow0 + l15) * 144 + lq * 16; const LAS unsigned char* bp = B + (brow0 + l15) * 144 + lq * 16;
#pragma unroll
    for (int ks = 0; ks < 2; ++ks) acc = __builtin_amdgcn_mfma_f32_16x16x32_bf16(*(const LAS bf16x8*)(ap + ks * 64), *(const LAS bf16x8*)(bp + ks * 64), acc, 0, 0, 0);
    return acc;
}
__device__ __forceinline__ void st16(LAS unsigned char* lds, int region, int row, int col, float v) { *(LAS bf16_t*)(lds + region + row * 144 + col * 2) = (bf16_t)(cvtpk(v, 0.f) & 0xffffu); }

struct PrepRegs { u32x4 cu, pv; };
__device__ __forceinline__ void rwkv_prep_loads(PrepRegs& R, int l, const bf16_t* P, const unsigned char* ws, int cid) {
    const int tid = tid_fresh();
    const int bh = cid >> 7, cc = cid & 127, b = bh >> 2;
    const size_t tok0 = (size_t)b * SEQ + cc * 64;
    {
        const int t = tid >> 3, seg = tid & 7;
        const bf16_t* pr = P + (tok0 + t) * NP + T_MISC * 256 + 8 * seg;
        R.cu = *(const u32x4*)pr;
        u32x4 z = {0u, 0u, 0u, 0u}; R.pv = z;
        if (cc * 64 + t > 0) R.pv = *(const u32x4*)(pr - NP);
    }
}
__device__ __forceinline__ void rwkv_prep_item(LAS unsigned char* lds, KArgs* a, int l, const bf16_t* P, bf16_t* Y, unsigned char* ws, int cid, const PrepRegs& R) {
    const int tid = tid_fresh(), lane = tid & 63, r32 = lane & 31, hi = lane >> 5;
    const int wid = __builtin_amdgcn_readfirstlane(tid >> 6);
    const int bh = cid >> 7, cc = cid & 127, b = bh >> 2, h = bh & 3;
    const size_t tok0 = (size_t)b * SEQ + cc * 64;
    const int c = h * 64 + lane;
    const float* mu = a->in[4] + l * 832;
    const float mu_r = mu[c], mu_k = mu[256 + c], mu_v = mu[512 + c];
    const float w0c = a->in[5][l * 256 + c], a0c = a->in[7][l * 256 + c], kkc = a->in[9][l * 256 + c], kac = a->in[10][l * 256 + c], rkc = a->in[11][l * 256 + c];
    const int l15 = lane & 15, lq = lane >> 4;
    bf16x8 bwv[2], bav[2];
    {
        const bf16_t* w2T = (const bf16_t*)(ws + WS_LORA) + (size_t)(l * 2 + 0) * 8192; const bf16_t* a2T = (const bf16_t*)(ws + WS_LORA) + (size_t)(l * 2 + 1) * 8192;
#pragma unroll
        for (int q = 0; q < 2; ++q) {
            const int nt = (wid >> 2) * 2 + q;
            bwv[q] = *(const bf16x8*)(w2T + (h * 64 + 16 * nt + l15) * 32 + 8 * lq);
            bav[q] = *(const bf16x8*)(a2T + (h * 64 + 16 * nt + l15) * 32 + 8 * lq);
        }
    }
    float r9[9], k9[9], v9[9];
    {
        const bf16_t* p0 = P + (tok0 + 8 * wid) * NP + c;
#pragma unroll
        for (int n = 0; n < 9; ++n) {
            const bool ok = (n > 0) || (cc * 64 + 8 * wid > 0);
            const bf16_t* pr = p0 + (ptrdiff_t)(n - 1) * NP;
            r9[n] = ok ? bf2f(pr[T_RR * 256]) : 0.f; k9[n] = ok ? bf2f(pr[T_RK * 256]) : 0.f; v9[n] = ok ? bf2f(pr[T_RV * 256]) : 0.f;
        }
    }
    {
        const int t = tid >> 3, seg = tid & 7;
        const u32x4 cu = R.cu, pv = R.pv;
        const f32x4 m0 = *(const f32x4*)(mu + 768 + 8 * seg), m1 = *(const f32x4*)(mu + 768 + 8 * seg + 4);
        float v[8] = {bflo(cu.x), bfhi(cu.x), bflo(cu.y), bfhi(cu.y), bflo(cu.z), bfhi(cu.z), bflo(cu.w), bfhi(cu.w)};
        const float q[8] = {bflo(pv.x), bfhi(pv.x), bflo(pv.y), bfhi(pv.y), bflo(pv.z), bfhi(pv.z), bflo(pv.w), bfhi(pv.w)};
#pragma unroll
        for (int e = 0; e < 8; ++e) { v[e] += (q[e] - v[e]) * (e < 4 ? m0[e] : m1[e - 4]); if (seg < 4) v[e] = tanh_(v[e]); }
        *(LAS bf16x8*)(lds + L_MAK + t * 144 + seg * 16) = pack8(v[0], v[1], v[2], v[3], v[4], v[5], v[6], v[7]);
    }
    BAR_LDS();
    {
        const int rt = wid & 3;
        const bf16x8 aw_ = *(const LAS bf16x8*)(lds + L_MAK + (16 * rt + l15) * 144 + lq * 16);
        const bf16x8 aa_ = *(const LAS bf16x8*)(lds + L_MAK + (16 * rt + l15) * 144 + 64 + lq * 16);
        LAS float* AW = (LAS float*)(lds + L_MAB); LAS float* AA = (LAS float*)(lds + L_AF);
#pragma unroll
        for (int q = 0; q < 2; ++q) {
            const int nt = (wid >> 2) * 2 + q;
            const bf16x8 bw_ = bwv[q], ba_ = bav[q];
            f32x4 z = {0.f, 0.f, 0.f, 0.f};
            const f32x4 cw = __builtin_amdgcn_mfma_f32_16x16x32_bf16(aw_, bw_, z, 0, 0, 0);
            const f32x4 ca = __builtin_amdgcn_mfma_f32_16x16x32_bf16(aa_, ba_, z, 0, 0, 0);
#pragma unroll
            for (int rg = 0; rg < 4; ++rg) { AW[(16 * rt + 4 * lq + rg) * 64 + 16 * nt + l15] = cw[rg]; AA[(16 * rt + 4 * lq + rg) * 64 + 16 * nt + l15] = ca[rg]; }
        }
    }
    BAR_LDS();
    float rr[8], kq[8], vv[8], kn[8], bb[8], lwv[8];
    {
        const LAS float* AW = (const LAS float*)(lds + L_MAB); const LAS float* AA = (const LAS float*)(lds + L_AF);
#pragma unroll
        for (int n = 0; n < 8; ++n) {
            const int tk = 8 * wid + n;
            const float r = r9[n + 1] + (r9[n] - r9[n + 1]) * mu_r, k = k9[n + 1] + (k9[n] - k9[n + 1]) * mu_k, v = v9[n + 1] + (v9[n] - v9[n + 1]) * mu_v;
            const float aw = AW[tk * 64 + lane], aa = AA[tk * 64 + lane];

            const float alpha = sigm(a0c + aa);
            const float kkr = k * kkc;
            const float ssq = wsum(kkr * kkr);
            const float kk = kkr * rsqrtf(fmaxf(ssq, 1e-12f));
            const float kmv = k * (1.f + (alpha - 1.f) * kac);
            const float bon = wsum(r * kmv * rkc);
            Y[(tok0 + tk) * DM + 512 + c] = (bf16_t)(cvtpk(bon * v, 0.f) & 0xffffu);
            rr[n] = r; kq[n] = kmv; vv[n] = v; kn[n] = kk; bb[n] = kk * alpha; lwv[n] = -0.60653065971f * sigm(w0c + aw);
        }
    }
    float cumv[8]; float run = 0.f;
#pragma unroll
    for (int n = 0; n < 8; ++n) { run += lwv[n]; cumv[n] = run; }
    LAS float* Ltot = (LAS float*)(lds + L_CUM);
    Ltot[wid * 64 + lane] = run;
    BAR_LDS();
    float off = 0.f, tot = 0.f;
#pragma unroll
    for (int w = 0; w < 8; ++w) { const float tv = Ltot[w * 64 + lane]; if (w < wid) off += tv; tot += tv; }
    float bh8[8], kh8[8];
    const float e_off = __expf(off), e_tot = __expf(tot);
    float e_pos_prev = e_off;
#pragma unroll
    for (int n = 0; n < 8; ++n) {
        const int tk = 8 * wid + n;
        const float cm = cumv[n] + off;
        const float e_pos = __expf(cm), e_neg = __builtin_amdgcn_rcpf(e_pos), e_prev = (n == 0) ? e_off : e_pos_prev, e_end = e_tot * e_neg;
        e_pos_prev = e_pos;
        const float at = -kn[n] * e_prev;
        ((LAS float*)(lds + L_AF))[tk * 64 + lane] = at;
        st16(lds, L_AT, tk, lane, at); st16(lds, L_BT, tk, lane, bb[n] * e_neg); st16(lds, L_KT, tk, lane, kq[n] * e_neg); st16(lds, L_RT, tk, lane, rr[n] * e_pos);
        bh8[n] = bb[n] * e_end; kh8[n] = kq[n] * e_end;
    }
    *(LAS bf16x8*)(lds + L_VT + lane * 144 + 16 * wid) = pack8(vv[0], vv[1], vv[2], vv[3], vv[4], vv[5], vv[6], vv[7]);
    *(LAS bf16x8*)(lds + L_BH + lane * 144 + 16 * wid) = pack8(bh8[0], bh8[1], bh8[2], bh8[3], bh8[4], bh8[5], bh8[6], bh8[7]);
    *(LAS bf16x8*)(lds + L_KH + lane * 144 + 16 * wid) = pack8(kh8[0], kh8[1], kh8[2], kh8[3], kh8[4], kh8[5], kh8[6], kh8[7]);
    if (wid == 0) ((LAS float*)(lds + L_GC))[lane] = __expf(tot);
    BAR_LDS();
    {
        const int p = wid >> 1, tm = wid & 1;
        const int Areg = (p & 1) ? L_KT : L_BT, Breg = (p < 2) ? L_AT : L_RT;
#pragma unroll
        for (int tn = 0; tn < 2; ++tn) {
            f32x16 acc;
#pragma unroll
            for (int r = 0; r < 16; ++r) acc[r] = 0.f;
            const int n_ = 32 * tn + r32, lim_ = n_ + (p >> 1);
            if (tm <= tn) acc = mm32(acc, lds + Areg, lds + Breg, tm, tn, r32, hi);
            if (tm == tn) {
#pragma unroll
                for (int r = 0; r < 16; ++r) { if (!(32 * tm + crow(r, hi) < lim_)) acc[r] = 0.f; }
            }
            if (p == 0) {
#pragma unroll
                for (int g = 0; g < 4; ++g) {
                    LAS float* mrow = (LAS float*)(lds + L_MAB) + n_ * 64 + 8 * tm + 2 * g + hi;
                    mrow[0] = acc[4 * g]; mrow[16] = acc[4 * g + 1]; mrow[32] = acc[4 * g + 2]; mrow[48] = acc[4 * g + 3];
                }
            } else {
                const int dst = (p == 1) ? L_MAK : ((p == 2) ? L_MRB : L_MRK);
#pragma unroll
                for (int g = 0; g < 4; ++g) { u32x2 o; o.x = cvtpk(acc[4 * g], acc[4 * g + 1]); o.y = cvtpk(acc[4 * g + 2], acc[4 * g + 3]); *(LAS u32x2*)(lds + dst + n_ * 144 + (32 * tm + 8 * g + 4 * hi) * 2) = o; }
            }
        }
    }
    BAR_LDS();
    if (wid < 4) {
        const int tm = wid >> 1, tn = wid & 1;
        f32x16 acc;
#pragma unroll
        for (int r = 0; r < 16; ++r) acc[r] = 0.f;
        acc = mm32(acc, lds + L_MAK, lds + L_VT, tm, tn, r32, hi);
        LAS float* X0 = (LAS float*)(lds + L_CUM);
#pragma unroll
        for (int r = 0; r < 16; ++r) X0[(32 * tm + crow(r, hi)) * 64 + 32 * tn + r32] = acc[r];
    }
    BAR_LDS();
#ifndef DIS_SOLVE
    {
        const int p4 = lane & 3, ci = (16 * wid + (lane >> 2)) & 63;
        const LAS float* rhs = (const LAS float*)(lds + ((wid < 4) ? L_AF : L_CUM)) + ci;
        const LAS float* Mb = (const LAS float*)(lds + L_MAB);
        const LAS float* Mp = Mb + 16 * p4;
        float xo[16];
#pragma unroll
        for (int i = 0; i < 16; ++i) xo[i] = 0.f;
#pragma unroll
        for (int rb = 0; rb < 16; ++rb) {
            const int t0 = 4 * rb;
            float a0 = 0.f, a1 = 0.f, a2 = 0.f, a3 = 0.f;
#pragma unroll
            for (int i4 = 0; i4 < (rb + 3) / 4; ++i4) {
                const f32x4 m0 = *(const LAS f32x4*)(Mp + (t0 + 0) * 64 + 4 * i4), m1 = *(const LAS f32x4*)(Mp + (t0 + 1) * 64 + 4 * i4);
                const f32x4 m2 = *(const LAS f32x4*)(Mp + (t0 + 2) * 64 + 4 * i4), m3 = *(const LAS f32x4*)(Mp + (t0 + 3) * 64 + 4 * i4);
#pragma unroll
                for (int e = 0; e < 4; ++e) if (4 * i4 + e < rb) { a0 += m0[e] * xo[4 * i4 + e]; a1 += m1[e] * xo[4 * i4 + e]; a2 += m2[e] * xo[4 * i4 + e]; a3 += m3[e] * xo[4 * i4 + e]; }
            }
            a0 += dpp_f<0xB1>(a0); a1 += dpp_f<0xB1>(a1); a2 += dpp_f<0xB1>(a2); a3 += dpp_f<0xB1>(a3);
            a0 += dpp_f<0x4E>(a0); a1 += dpp_f<0x4E>(a1); a2 += dpp_f<0x4E>(a2); a3 += dpp_f<0x4E>(a3);
            const float m10 = Mb[(t0 + 1) * 64 + rb], m20 = Mb[(t0 + 2) * 64 + rb], m21 = Mb[(t0 + 2) * 64 + 16 + rb];
            const float m30 = Mb[(t0 + 3) * 64 + rb], m31 = Mb[(t0 + 3) * 64 + 16 + rb], m32 = Mb[(t0 + 3) * 64 + 32 + rb];
            const float x0 = a0 + rhs[(t0 + 0) * 64];
            const float x1 = a1 + rhs[(t0 + 1) * 64] + m10 * x0;
            const float x2 = a2 + rhs[(t0 + 2) * 64] + m20 * x0 + m21 * x1;
            const float x3 = a3 + rhs[(t0 + 3) * 64] + m30 * x0 + m31 * x1 + m32 * x2;
            xo[rb] = (p4 == 0) ? x0 : ((p4 == 1) ? x1 : ((p4 == 2) ? x2 : x3));
        }
        LAS unsigned char* dst = lds + ((wid < 4) ? L_AT : L_BT) + ci * 144 + p4 * 2;
#pragma unroll
        for (int i = 0; i < 16; ++i) *(LAS bf16_t*)(dst + i * 8) = (bf16_t)(cvtpk(xo[i], 0.f) & 0xffffu);
    }
#endif
    BAR_LDS();
    bf16_t* AG = (bf16_t*)(ws + WS_AG) + (size_t)cid * 4096; bf16_t* QG = (bf16_t*)(ws + WS_QG) + (size_t)cid * 4096;
    bf16_t* DG = (bf16_t*)(ws + WS_DG) + (size_t)cid * 4096; bf16_t* Y0G = (bf16_t*)(ws + WS_Y0) + (size_t)cid * 4096;
    if (wid < 4) {
        const int tm = wid >> 1, tn = wid & 1, n_ = 32 * tn + r32;
        f32x16 acc;
#pragma unroll
        for (int g = 0; g < 4; ++g) { const u32x2 rv = *(const LAS u32x2*)(lds + L_RT + n_ * 144 + (32 * tm + 8 * g + 4 * hi) * 2); acc[4 * g] = bflo(rv.x); acc[4 * g + 1] = bfhi(rv.x); acc[4 * g + 2] = bflo(rv.y); acc[4 * g + 3] = bfhi(rv.y); }
        acc = mm32(acc, lds + L_AT, lds + L_MRB, tm, tn, r32, hi);
        bf16_t* qg = QG + n_ * 64 + 32 * tm + 4 * hi;
#pragma unroll
        for (int g = 0; g < 4; ++g) { u32x2 o; o.x = cvtpk(acc[4 * g], acc[4 * g + 1]); o.y = cvtpk(acc[4 * g + 2], acc[4 * g + 3]); *(u32x2*)(qg + 8 * g) = o; }
        f32x16 d;
#pragma unroll
        for (int r = 0; r < 16; ++r) d[r] = 0.f;
        d = mm32(d, lds + L_BH, lds + L_BT, tm, tn, r32, hi);
        d = mm32(d, lds + L_KH, lds + L_VT, tm, tn, r32, hi);
        bf16_t* dg = DG + (wid * 128 + lane) * 8;
        *(bf16x8*)dg = pack8(d[0], d[1], d[2], d[3], d[4], d[5], d[6], d[7]);
        *(bf16x8*)(dg + 512) = pack8(d[8], d[9], d[10], d[11], d[12], d[13], d[14], d[15]);
    } else {
        const int w4 = wid - 4, tm = w4 >> 1, tn = w4 & 1, n_ = 32 * tn + r32;
        f32x16 acc;
        const float gc = ((const LAS float*)(lds + L_GC))[n_];
#pragma unroll
        for (int r = 0; r < 16; ++r) acc[r] = (32 * tm + crow(r, hi) == n_) ? gc : 0.f;
        acc = mm32(acc, lds + L_AT, lds + L_BH, tm, tn, r32, hi);
        bf16_t* ag = AG + n_ * 64 + 32 * tm + 4 * hi;
#pragma unroll
        for (int g = 0; g < 4; ++g) { u32x2 o; o.x = cvtpk(acc[4 * g], acc[4 * g + 1]); o.y = cvtpk(acc[4 * g + 2], acc[4 * g + 3]); *(u32x2*)(ag + 8 * g) = o; }
        const int l15 = lane & 15, lq = lane >> 4;
#pragma unroll
        for (int nt = 0; nt < 4; ++nt) {
            f32x4 y = {0.f, 0.f, 0.f, 0.f};
            y = mm16(y, lds + L_MRB, 16 * w4, lds + L_BT, 16 * nt, l15, lq);
            y = mm16(y, lds + L_MRK, 16 * w4, lds + L_VT, 16 * nt, l15, lq);
            bf16_t* yg = Y0G + ((w4 * 4 + nt) * 4) * 64 + lane;
#pragma unroll
            for (int rg = 0; rg < 4; ++rg) yg[rg * 64] = (bf16_t)(cvtpk(y[rg], 0.f) & 0xffffu);
        }
    }
    BAR_LDS();
}

constexpr size_t WS_HG = 244 * MiB, WS_GW = 252 * MiB;
__device__ __forceinline__ void rwkv_chain_item(LAS unsigned char* lds, const unsigned char* ws_c, unsigned char* ws, int bh) {
    constexpr int RBASE = 18432, SLOT = 17408;
    const int tid = tid_fresh(), lane = tid & 63, r32 = lane & 31, hi = lane >> 5;
    const int wid = __builtin_amdgcn_readfirstlane(tid >> 6);
    const int t2 = tid & 255;
    const bf16_t* AG = (const bf16_t*)(ws_c + WS_AG) + (size_t)bh * 128 * 4096;
    const bf16_t* DG = (const bf16_t*)(ws_c + WS_DG) + (size_t)bh * 128 * 4096;
    bf16_t* HG = (bf16_t*)(ws + WS_HG) + (size_t)bh * 128 * 4096;
    for (int i = tid; i < 2 * 9216 / 4; i += NTHR) ((LAS unsigned*)lds)[i] = 0u;
    u32x4 B0a0, B0a1, B0d0, B0d1, B1a0, B1a1, B1d0, B1d1, B2a0, B2a1, B2d0, B2d1, B3a0, B3a1, B3d0, B3d1, B4a0, B4a1, B4d0, B4d1, B5a0, B5a1, B5d0, B5d1, B6a0, B6a1, B6d0, B6d1;
#define CB_LOAD(X, cc_) do { if ((cc_) < 128) { const size_t co_ = (size_t)(cc_) * 4096; X##a0 = *(const u32x4*)(AG + co_ + t2 * 8); X##a1 = *(const u32x4*)(AG + co_ + 2048 + t2 * 8); \
        X##d0 = *(const u32x4*)(DG + co_ + t2 * 8); X##d1 = *(const u32x4*)(DG + co_ + 2048 + t2 * 8); } } while (0)
#define CB_STORE(X, k_) do { LAS unsigned char* sb_ = lds + RBASE + (k_) * SLOT; \
        *(LAS u32x4*)(sb_ + (t2 >> 3) * 144 + (t2 & 7) * 16) = X##a0; *(LAS u32x4*)(sb_ + (32 + (t2 >> 3)) * 144 + (t2 & 7) * 16) = X##a1; \
        *(LAS u32x4*)(sb_ + 9216 + t2 * 16) = X##d0; *(LAS u32x4*)(sb_ + 9216 + 4096 + t2 * 16) = X##d1; } while (0)
#define CB_STEP(k_, c_) do { if ((c_) < 128) { if (wid < 4) { const LAS unsigned char* sb = lds + RBASE + (k_) * SLOT; const LAS unsigned char* Sc = lds + ((c_) & 1) * 9216; LAS unsigned char* Sn = lds + (((c_) & 1) ^ 1) * 9216; \
            const int tm = wid >> 1, tn = wid & 1; f32x16 acc, acc2; const LAS u32x4* dp = (const LAS u32x4*)(sb + 9216 + (wid * 128 + lane) * 16); \
            { const u32x4 da = dp[0], db = dp[64]; \
              acc[0] = bflo(da.x); acc[1] = bfhi(da.x); acc[2] = bflo(da.y); acc[3] = bfhi(da.y); acc[4] = bflo(da.z); acc[5] = bfhi(da.z); acc[6] = bflo(da.w); acc[7] = bfhi(da.w); \
              acc[8] = bflo(db.x); acc[9] = bfhi(db.x); acc[10] = bflo(db.y); acc[11] = bfhi(db.y); acc[12] = bflo(db.z); acc[13] = bfhi(db.z); acc[14] = bflo(db.w); acc[15] = bfhi(db.w); } \
            _Pragma("unroll") for (int r = 0; r < 16; ++r) acc2[r] = 0.f; \
            { const LAS unsigned char* ap = sb + (32 * tm + r32) * 144 + hi * 16; const LAS unsigned char* bp = Sc + (32 * tn + r32) * 144 + hi * 16; \
              acc = __builtin_amdgcn_mfma_f32_32x32x16_bf16(*(const LAS bf16x8*)(ap), *(const LAS bf16x8*)(bp), acc, 0, 0, 0); \
              acc2 = __builtin_amdgcn_mfma_f32_32x32x16_bf16(*(const LAS bf16x8*)(ap + 64), *(const LAS bf16x8*)(bp + 64), acc2, 0, 0, 0); \
              acc = __builtin_amdgcn_mfma_f32_32x32x16_bf16(*(const LAS bf16x8*)(ap + 32), *(const LAS bf16x8*)(bp + 32), acc, 0, 0, 0); \
              acc2 = __builtin_amdgcn_mfma_f32_32x32x16_bf16(*(const LAS bf16x8*)(ap + 96), *(const LAS bf16x8*)(bp + 96), acc2, 0, 0, 0); } \
            _Pragma("unroll") for (int r = 0; r < 16; ++r) acc[r] += acc2[r]; \
            const u32x4 h0_ = *(const LAS u32x4*)(Sc + (t2 >> 3) * 144 + (t2 & 7) * 16), h1_ = *(const LAS u32x4*)(Sc + (32 + (t2 >> 3)) * 144 + (t2 & 7) * 16); \
            _Pragma("unroll") for (int g = 0; g < 4; ++g) { u32x2 o; o.x = cvtpk(acc[4 * g], acc[4 * g + 1]); o.y = cvtpk(acc[4 * g + 2], acc[4 * g + 3]); *(LAS u32x2*)(Sn + (32 * tn + r32) * 144 + (32 * tm + 8 * g + 4 * hi) * 2) = o; } \
            *(u32x4*)(HG + (size_t)(c_) * 4096 + t2 * 8) = h0_; *(u32x4*)(HG + (size_t)(c_) * 4096 + 2048 + t2 * 8) = h1_; } \
        BAR_LDS(); } } while (0)
#define CB_FEED(X, k_, c_) do { if (wid >= 4) { if ((c_) + 7 < 128) CB_STORE(X, k_); CB_LOAD(X, (c_) + 14); } } while (0)
    if (wid >= 4) {
        CB_LOAD(B0, 0); CB_LOAD(B1, 1); CB_LOAD(B2, 2); CB_LOAD(B3, 3); CB_LOAD(B4, 4); CB_LOAD(B5, 5); CB_LOAD(B6, 6);
        CB_STORE(B0, 0); CB_STORE(B1, 1); CB_STORE(B2, 2); CB_STORE(B3, 3); CB_STORE(B4, 4); CB_STORE(B5, 5); CB_STORE(B6, 6);
        CB_LOAD(B0, 7); CB_LOAD(B1, 8); CB_LOAD(B2, 9); CB_LOAD(B3, 10); CB_LOAD(B4, 11); CB_LOAD(B5, 12); CB_LOAD(B6, 13);
    }
    BAR_LDS();
#pragma unroll 1
    for (int bk = 0; bk < 19; ++bk) {
        const int c0 = 7 * bk;
        CB_STEP(0, c0); CB_FEED(B0, 0, c0);
        CB_STEP(1, c0 + 1); CB_FEED(B1, 1, c0 + 1);
        CB_STEP(2, c0 + 2); CB_FEED(B2, 2, c0 + 2);
        CB_STEP(3, c0 + 3); CB_FEED(B3, 3, c0 + 3);
        CB_STEP(4, c0 + 4); CB_FEED(B4, 4, c0 + 4);
        CB_STEP(5, c0 + 5); CB_FEED(B5, 5, c0 + 5);
        CB_STEP(6, c0 + 6); CB_FEED(B6, 6, c0 + 6);
    }
#undef CB_FEED
#undef CB_LOAD
#undef CB_STORE
#undef CB_STEP
}
__device__ __forceinline__ void rwkv_out_pair(KArgs* a, int l, const bf16_t* P, bf16_t* Y, const unsigned char* ws, int item0, int item1, int lane) {
    const int l15 = lane & 15, lq = lane >> 4;
    bf16x8 qa[2][2], hb[2][4][2]; bf16_t y0[2][4][4];
    size_t tokb[2]; int hh[2];
#pragma unroll
    for (int u = 0; u < 2; ++u) {
        const int item = (u && item1 >= 0) ? item1 : item0;
        const int cid = item >> 2, w4 = item & 3;
        const int bh = cid >> 7, cc = cid & 127, b = bh >> 2, h = bh & 3;
        hh[u] = h; tokb[u] = (size_t)b * SEQ + cc * 64 + 16 * w4 + 4 * lq;
        const bf16_t* QG = (const bf16_t*)(ws + WS_QG) + (size_t)cid * 4096; const bf16_t* HG = (const bf16_t*)(ws + WS_HG) + (size_t)cid * 4096;
        const bf16_t* Y0G = (const bf16_t*)(ws + WS_Y0) + (size_t)cid * 4096;
#pragma unroll
        for (int ks = 0; ks < 2; ++ks) qa[u][ks] = *(const bf16x8*)(QG + (16 * w4 + l15) * 64 + 32 * ks + 8 * lq);
#pragma unroll
        for (int nt = 0; nt < 4; ++nt) {
#pragma unroll
            for (int ks = 0; ks < 2; ++ks) hb[u][nt][ks] = *(const bf16x8*)(HG + (16 * nt + l15) * 64 + 32 * ks + 8 * lq);
            const bf16_t* yp = Y0G + ((w4 * 4 + nt) * 4) * 64 + lane;
#pragma unroll
            for (int rg = 0; rg < 4; ++rg) {
                y0[u][nt][rg] = yp[rg * 64];
            }
        }
    }
#pragma unroll
    for (int u = 0; u < 2; ++u) {
        if (u == 1 && item1 < 0) break;
        const int h = hh[u];
        bf16_t ev[4][4], gv[4][4];
#pragma unroll
        for (int nt = 0; nt < 4; ++nt)
#pragma unroll
            for (int rg = 0; rg < 4; ++rg) { const int ch = h * 64 + 16 * nt + l15; ev[nt][rg] = Y[(tokb[u] + rg) * DM + 512 + ch]; gv[nt][rg] = P[(tokb[u] + rg) * NP + T_RG * 256 + ch]; }
        f32x4 y[4];
#pragma unroll
        for (int nt = 0; nt < 4; ++nt) {
#pragma unroll
            for (int rg = 0; rg < 4; ++rg) y[nt][rg] = bf2f(y0[u][nt][rg]);
#pragma unroll
            for (int ks = 0; ks < 2; ++ks) y[nt] = __builtin_amdgcn_mfma_f32_16x16x32_bf16(qa[u][ks], hb[u][nt][ks], y[nt], 0, 0, 0);
        }
        float lng[4], lnb[4];
#pragma unroll
        for (int nt = 0; nt < 4; ++nt) { lng[nt] = a->in[12][l * 256 + h * 64 + 16 * nt + l15]; lnb[nt] = a->in[13][l * 256 + h * 64 + 16 * nt + l15]; }
#pragma unroll
        for (int rg = 0; rg < 4; ++rg) {
            const float mean = rowsum16((y[0][rg] + y[1][rg]) + (y[2][rg] + y[3][rg])) * (1.f / 64.f);
            const float d0 = y[0][rg] - mean, d1 = y[1][rg] - mean, d2 = y[2][rg] - mean, d3 = y[3][rg] - mean;
            const float rs = rsqrtf(rowsum16((d0 * d0 + d1 * d1) + (d2 * d2 + d3 * d3)) * (1.f / 64.f) + 64e-5f);
            const float dd[4] = {d0, d1, d2, d3};
#pragma unroll
            for (int nt = 0; nt < 4; ++nt) {
                const int ch = h * 64 + 16 * nt + l15;
                const float e = bf2f(ev[nt][rg]), g = bf2f(gv[nt][rg]);
                const float ov = (dd[nt] * rs * lng[nt] + lnb[nt] + e) * g * sigm(g);
                Y[(tokb[u] + rg) * DM + 512 + ch] = (bf16_t)(cvtpk(ov, 0.f) & 0xffffu);
            }
        }
    }
}

__device__ __forceinline__ void fgate_item(KArgs* a, int l, const bf16_t* P, unsigned char* ws, int it, int lane) {
    float* Fl = (float*)(ws + WS_FL); float* Ftot = (float*)(ws + WS_FTOT);
    const int bh = it >> 5, cch = it & 31, b = bh >> 2, h = bh & 3;
    const float bfg = a->in[3][l * 4 + h];
    float v[4];
#pragma unroll
    for (int e = 0; e < 4; ++e) {
        const size_t t = (size_t)b * SEQ + cch * 256 + 4 * lane + e;
        const float xx = bf2f(P[t * NP + T_MISC * 256 + 64 + h]) + bfg;
        v[e] = (fminf(xx, 0.f) - __logf(1.f + __expf(-fabsf(xx)))) * LOG2E;
    }
    v[1] += v[0]; v[2] += v[1]; v[3] += v[2];
    const float tot = v[3]; float inc = tot;
#pragma unroll
    for (int o = 1; o < 64; o <<= 1) { const float nb = __shfl_up(inc, o); if (lane >= o) inc += nb; }
    const float ex = inc - tot;
    f32x4 o4 = {v[0] + ex, v[1] + ex, v[2] + ex, v[3] + ex};
    *(f32x4*)(Fl + (size_t)bh * SEQ + cch * 256 + 4 * lane) = o4;
    if (lane == 63) Ftot[bh * 32 + cch] = inc;
    float km = 0.f;
#pragma unroll
    for (int e = 0; e < 4; ++e) {
        const bf16_t* kp = P + ((size_t)b * SEQ + cch * 256 + 4 * lane + e) * NP + 256 + h * 64;
        float s2 = 0.f;
#pragma unroll
        for (int i = 0; i < 8; ++i) { const u32x4 kv = *(const u32x4*)(kp + 8 * i);
            s2 += (bflo(kv.x) * bflo(kv.x) + bfhi(kv.x) * bfhi(kv.x)) + (bflo(kv.y) * bflo(kv.y) + bfhi(kv.y) * bfhi(kv.y)) + (bflo(kv.z) * bflo(kv.z) + bfhi(kv.z) * bfhi(kv.z)) + (bflo(kv.w) * bflo(kv.w) + bfhi(kv.w) * bfhi(kv.w)); }
        km = fmaxf(km, s2);
    }
#pragma unroll
    for (int o = 1; o < 64; o <<= 1) km = fmaxf(km, __shfl_xor(km, o));
    if (lane == 0) ((float*)(ws + WS_KMAX))[bh * 32 + cch] = km;
}

__device__ __forceinline__ void lru_prep_item(LAS unsigned char* lds, KArgs* a, int l, const bf16_t* P, float* LH, float* LA, const unsigned char* ws, unsigned char* ws_w, int q) {
    constexpr int XP = 528;
    const int tid = tid_fresh(), lane = tid & 63, r32 = lane & 31, hi = lane >> 5;
    const int wid = __builtin_amdgcn_readfirstlane(tid >> 6);
    LAS unsigned char* XB_ = lds;
    LAS float* U = (LAS float*)(lds + 34816);
    LAS bf16_t* LA16 = (LAS bf16_t*)(lds + 100352);
    const int c = tid & 255, th = tid >> 8;
    const int t0 = q * 64, b = t0 / SEQ, s0 = t0 % SEQ;
    bf16x8 gba[2][4], gbx[2][4];
    {
        const int n = wid >> 1;
        const bf16_t* WA = (const bf16_t*)(ws + WS_GW) + (size_t)((l * 2 + 0) * 4 + n) * 4096; const bf16_t* WX = (const bf16_t*)(ws + WS_GW) + (size_t)((l * 2 + 1) * 4 + n) * 4096;
#pragma unroll
        for (int tn = 0; tn < 2; ++tn)
#pragma unroll
            for (int ks = 0; ks < 4; ++ks) { gba[tn][ks] = *(const bf16x8*)(WA + (32 * tn + r32) * 64 + 16 * ks + 8 * hi); gbx[tn][ks] = *(const bf16x8*)(WX + (32 * tn + r32) * 64 + 16 * ks + 8 * hi); }
    }
    {
        const float* cw = a->in[14] + l * 4 * 256; const float cb = a->in[15][l * 256 + c];
        const float cw0 = cw[c], cw1 = cw[256 + c], cw2 = cw[512 + c], cw3 = cw[768 + c];
        const int sb = s0 + th * 32;
        const bf16_t* px = P + (size_t)b * SEQ * NP + T_LX * 256 + c;
        float xv[35];
#pragma unroll
        for (int i = 0; i < 35; ++i) { const int sx = sb - 3 + i; xv[i] = (sx >= 0) ? bf2f(px[(ptrdiff_t)sx * NP]) : 0.f; }
#pragma unroll
        for (int tk = 0; tk < 32; ++tk) {
            const float v = cb + cw0 * xv[tk] + cw1 * xv[tk + 1] + cw2 * xv[tk + 2] + cw3 * xv[tk + 3];
            *(LAS bf16_t*)(XB_ + (th * 32 + tk) * XP + c * 2) = (bf16_t)(cvtpk(v, 0.f) & 0xffffu);
        }
    }
    BAR_LDS();
    {
        const int n = wid >> 1, tm = wid & 1;
#pragma unroll
        for (int tn = 0; tn < 2; ++tn) {
            f32x16 ca, cx;
#pragma unroll
            for (int r = 0; r < 16; ++r) { ca[r] = 0.f; cx[r] = 0.f; }
#pragma unroll
            for (int ks = 0; ks < 4; ++ks) {
                const bf16x8 av = *(const LAS bf16x8*)(XB_ + (32 * tm + r32) * XP + (n * 64 + 16 * ks + 8 * hi) * 2);
                const bf16x8 ba = gba[tn][ks], bx = gbx[tn][ks];
                ca = __builtin_amdgcn_mfma_f32_32x32x16_bf16(av, ba, ca, 0, 0, 0);
                cx = __builtin_amdgcn_mfma_f32_32x32x16_bf16(av, bx, cx, 0, 0, 0);
            }
            const int ch = n * 64 + 32 * tn + r32;
            const float bav = a->in[17][l * 256 + ch], bxv = a->in[19][l * 256 + ch], lsp = softplus_(-a->in[20][l * 256 + ch]);
#pragma unroll
            for (int r = 0; r < 16; ++r) {
                const int t = 32 * tm + (r & 3) + 8 * (r >> 2) + 4 * hi;
                const float rg = sigm(ca[r] + bav), ig = sigm(cx[r] + bxv);
                const float la = -8.f * rg * lsp;
                const float xcv = bf2f(*(const LAS bf16_t*)(XB_ + t * XP + ch * 2));
                U[t * 256 + ch] = __builtin_amdgcn_sqrtf(1.f - __expf(2.f * la)) * ig * xcv;
                LA16[t * 256 + ch] = (bf16_t)(cvtpk(la, 0.f) & 0xffffu);
            }
        }
    }
    BAR_LDS();
    if (wid == 4) fgate_item(a, l, P, ws_w, q, lane);
    if (tid < 256) {
        float h = 0.f, sl = 0.f;
#pragma unroll 8
        for (int t = 0; t < 64; ++t) {
            const float la = bf2f(LA16[t * 256 + c]);
            h = __expf(la) * h + U[t * 256 + c]; sl += la;
            const size_t o = (size_t)(t0 + t) * 256 + c;
            LH[o] = h; LA[o] = __expf(sl);
        }
    }
    BAR_LDS();
}
__device__ __forceinline__ void lru_carry_item(const float* LH, const float* LA, float* HIN) {
    const int tid = tid_fresh(), c = tid & 255, b = tid >> 8;
    float hin = 0.f;
#pragma unroll 8
    for (int cc = 0; cc < 128; ++cc) {
        const int q = b * 128 + cc;
        HIN[q * 256 + c] = hin;
        const size_t o = (size_t)(q * 64 + 63) * 256 + c;
        hin = LA[o] * hin + LH[o];
    }
}
__device__ __forceinline__ void lru_apply_item(const bf16_t* P, bf16_t* Y, const float* LH, const float* LA, const float* HIN, int q) {
    const int tid = tid_fresh(), c = tid & 255, th = tid >> 8;
    const float hin = HIN[q * 256 + c];
    const int t0 = q * 64 + th * 32;
#pragma unroll
    for (int tk = 0; tk < 32; ++tk) {
        const size_t t = (size_t)(t0 + tk);
        const float hv = LH[t * 256 + c] + LA[t * 256 + c] * hin;
        const float g = bf2f(P[t * NP + T_LG * 256 + c]);
        const float out = hv * g * sigm(g);
        Y[t * DM + 768 + c] = (bf16_t)(cvtpk(out, 0.f) & 0xffffu);
    }
}

#define XB_TMO      128
#define XB_XCNT(j)  (256  + 64 * (j))
#define XB_XSUB(j)  (1280 + 64 * (j))
#define XB_XGEN(j)  (2304 + 64 * (j))
#define XB_TOP      3328
#define XB_TOPGEN   3392
#define XCD_BAR_WORDS 3456
#define XB_SPIN_CAP (1u << 18)

__device__ __forceinline__ unsigned xb_ld(unsigned* p)              { return __hip_atomic_load(p, __ATOMIC_RELAXED, __HIP_MEMORY_SCOPE_AGENT); }
__device__ __forceinline__ unsigned xb_add(unsigned* p, unsigned v) { return __hip_atomic_fetch_add(p, v, __ATOMIC_RELAXED, __HIP_MEMORY_SCOPE_AGENT); }
__device__ __forceinline__ unsigned xb_xcc_id() { return (unsigned)__builtin_amdgcn_s_getreg((3 << 11) | 20) & 0xFu; }
#define XB_SPIN(cond, bar) do { unsigned _sp = 0; while (cond) { __builtin_amdgcn_s_sleep(1); \
    if ((++_sp & 255u) == 0u) { if (xb_ld(&(bar)[XB_TMO])) break; if (_sp > XB_SPIN_CAP) { atomicAdd(&(bar)[XB_TMO], 1u); break; } } } } while (0)

struct XcdBarrier {
    unsigned* bar; unsigned x;
    volatile LAS unsigned* st;
};

__device__ __forceinline__ XcdBarrier xcd_barrier_post(unsigned* bar, volatile LAS unsigned* st) {
    XcdBarrier b; b.bar = bar; b.x = xb_xcc_id(); b.st = st;
    if (threadIdx.x == 0) (void)xb_add(&bar[XB_XCNT(b.x)], 1u);
    return b;
}
__device__ __forceinline__ void xcd_barrier_complete(unsigned* bar, unsigned x, unsigned& nloc, unsigned& nx) {
    const unsigned G = gridDim.x * gridDim.y * gridDim.z;
    unsigned sum, cnt, mine, sp = 0u;
    for (;;) {
        sum = 0u; cnt = 0u; mine = 0u;
#pragma unroll
        for (unsigned j = 0; j < 16; ++j) { const unsigned c = xb_ld(&bar[XB_XCNT(j)]); sum += c; cnt += (c > 0u) ? 1u : 0u; mine = (j == x) ? c : mine; }
        if (sum == G) break;
        __builtin_amdgcn_s_sleep(1);
        if ((++sp & 255u) == 0u) { if (xb_ld(&bar[XB_TMO])) break; if (sp > XB_SPIN_CAP) { atomicAdd(&bar[XB_TMO], 1u); break; } }
    }
    nloc = mine > 0u ? mine : 1u; nx = cnt > 0u ? cnt : 1u;
}

__device__ __forceinline__ void xcd_barrier(const XcdBarrier& b) {
    asm volatile("s_waitcnt vmcnt(0)" ::: "memory");
    __syncthreads();
    if (threadIdx.x == 0) {
        unsigned* bar = b.bar;
        __builtin_amdgcn_s_waitcnt(0);
        unsigned nloc = b.st[0], nx = b.st[1];
        if (nloc == 0u) { xcd_barrier_complete(bar, b.x, nloc, nx); b.st[0] = nloc; b.st[1] = nx; }
        const unsigned old = xb_add(&bar[XB_XSUB(b.x)], 1u);
        const unsigned gen = old / nloc;
        if (old + 1u == (gen + 1u) * nloc) {
            __builtin_amdgcn_fence(__ATOMIC_RELEASE, "agent");
            asm volatile("s_waitcnt vmcnt(0)" ::: "memory");
            const unsigned og = xb_add(&bar[XB_TOP], 1u);
            const unsigned tg = og / nx;
            if (og + 1u == (tg + 1u) * nx) xb_add(&bar[XB_TOPGEN], 1u);
            else XB_SPIN(xb_ld(&bar[XB_TOPGEN]) == tg, bar);
            __builtin_amdgcn_fence(__ATOMIC_ACQUIRE, "agent");
            xb_add(&bar[XB_XGEN(b.x)], 1u);
            asm volatile("s_waitcnt vmcnt(0)" ::: "memory");
        } else {
            XB_SPIN(xb_ld(&bar[XB_XGEN(b.x)]) == gen, bar);
            __builtin_amdgcn_fence(__ATOMIC_ACQUIRE, "agent");
            asm volatile("s_waitcnt vmcnt(0)" ::: "memory");
        }
    }
    __syncthreads();
}


constexpr int N_ITEMS = 9 + 512;
__global__ void __launch_bounds__(NTHR, 2) mega_fwd(Args a_unused) {
    extern __shared__ __attribute__((aligned(16))) unsigned char lds_raw[];
    LAS unsigned char* lds = (LAS unsigned char*)lds_raw;
    cg::grid_group grid = cg::this_grid();
    {
        for (int u = threadIdx.x; u < 64; u += NTHR) ((LAS unsigned*)(lds + 143360))[u] = 0u;
        __syncthreads();
    }
    {
        KArgs* a0_ = ARGP();
        (void)xcd_barrier_post((unsigned*)(a0_->ws + WS_BAR), (volatile LAS unsigned*)(lds + 143360 + 64));
    }
#if USE_CG_SYNC
#define GRID_SYNC() grid.sync()
#else
#define GRID_SYNC() do { XcdBarrier b_; b_.bar = (unsigned*)(ARGP()->ws + WS_BAR); b_.x = xb_xcc_id(); b_.st = (volatile LAS unsigned*)(lds + 143360 + 64); xcd_barrier(b_); } while (0)
#endif
#define TID (tid_fresh())
#define LANE (TID & 63)
#define WAVE (__builtin_amdgcn_readfirstlane(TID >> 6))
#define GRID_N ((int)gridDim.x)
#define GW ((int)blockIdx.x * 8 + WAVE)
#define NGW_ (GRID_N * 8)

#ifdef PROBE_P0X2
    for (int rep0_ = 0; rep0_ < 2; ++rep0_)
#endif
    {
        KArgs* a = ARGP(); unsigned char* ws = a->ws;
        unsigned* ctl = (unsigned*)(ws + WS_CTL); float* rowss = (float*)(ws + WS_ROWSS);
        bf16_t* WIN = (bf16_t*)(ws + WS_WIN); bf16_t* WOUT = (bf16_t*)(ws + WS_WOUT); bf16_t* XB = (bf16_t*)(ws + WS_XB);
        const float* x = a->in[0];
        const int tid = TID, lane = LANE, wave = WAVE, G = GRID_N, gw = GW, NGW = NGW_;
        for (int i = blockIdx.x * NTHR + tid; i < 2 * M; i += G * NTHR) rowss[M + i] = 0.f;
        if (blockIdx.x == 0 && tid < 16) ctl[tid] = 0u;
        for (int i = blockIdx.x * NTHR + tid; i < 32768; i += G * NTHR) {
            const int m = i & 31, cch = (i >> 5) & 255, g = (i >> 13) & 1, ll = i >> 14;
            const float v = a->in[g ? 8 : 6][(ll * 32 + m) * 256 + cch];
            ((bf16_t*)(ws + WS_LORA))[i] = (bf16_t)(cvtpk(v, 0.f) & 0xffffu);
        }
        for (int i = blockIdx.x * NTHR + tid; i < 65536; i += G * NTHR) {
            const int ii = i & 63, jj = (i >> 6) & 63, nh = (i >> 12) & 3, g = (i >> 14) & 1, ll = i >> 15;
            const float v = a->in[g ? 18 : 16][((ll * 4 + nh) * 64 + ii) * 64 + jj];
            ((bf16_t*)(ws + WS_GW))[i] = (bf16_t)(cvtpk(v, 0.f) & 0xffffu);
        }
        LAS float* scr = (LAS float*)(lds + wave * 16384);
        for (int it = gw; it < 1920; it += NGW) tr_item(a->in[2], NIN, a->in[1], true, WIN, DM, scr, it / 120, it % 120, lane);
        for (int m0 = gw; m0 < M; m0 += 4 * NGW) {
            f32x4 v[4][4];
#pragma unroll
            for (int u = 0; u < 4; ++u) { const int m = m0 + u * NGW; const f32x4* xr = (const f32x4*)(x + (size_t)(m < M ? m : m0) * DM) + lane;
#pragma unroll
                for (int j = 0; j < 4; ++j) v[u][j] = xr[64 * j]; }
#pragma unroll
            for (int u = 0; u < 4; ++u) { const int m = m0 + u * NGW; if (m >= M) break;
                u32x2* xo = (u32x2*)(XB + (size_t)m * DM) + lane; float ss = 0.f;
#pragma unroll
                for (int j = 0; j < 4; ++j) { const f32x4 t = v[u][j]; ss += (t[0] * t[0] + t[1] * t[1]) + (t[2] * t[2] + t[3] * t[3]); u32x2 w; w.x = cvtpk(t[0], t[1]); w.y = cvtpk(t[2], t[3]); xo[64 * j] = w; }
                ss = wsum(ss);
                if (lane == 0) rowss[m] = ss; }
        }
    }
    if (gridDim.x == 0x7fffffffu) grid.sync();
    GRID_SYNC();

#pragma unroll 1
    for (int l = 0; l < DEPTH; ++l) {
#ifndef DIS_P1
        {
            KArgs* a = ARGP(); unsigned char* ws = a->ws;
            pg8::Gemm g{(const bf16_t*)(ws + WS_XB), (const bf16_t*)(ws + WS_WIN) + (size_t)l * NP * DM, M, NP, DM};
            pg8::StaticOrder S; S.init(M, NP, GRID_N, (int)blockIdx.x);
            EpiIn E{(bf16_t*)(ws + WS_P), (const float*)(ws + WS_ROWSS) + l * M};
            pg8::gemm_phase<EpiIn, pg8::StaticOrder, true, true>(lds, g, S, E);
#ifdef PROBE_P1X2
            __syncthreads();
            pg8::gemm_phase<EpiIn, pg8::StaticOrder, true, true>(lds, g, S, E);
#endif
        }
#endif
        GRID_SYNC();
#ifdef PROBE_SYNC8
        GRID_SYNC(); GRID_SYNC(); GRID_SYNC(); GRID_SYNC();
#endif
#ifndef DIS_P2A
#ifdef PROBE_P2AX2
        for (int rep_ = 0; rep_ < 2; ++rep_)
#endif
        {
            KArgs* a = ARGP(); unsigned char* ws = a->ws;
            const bf16_t* P = (const bf16_t*)(ws + WS_P);
            const int G = GRID_N;
#ifdef PROBE_RWPREPX2
            for (int q = blockIdx.x; q < 1024; q += G) { PrepRegs pr_; rwkv_prep_loads(pr_, l, P, ws, q); rwkv_prep_item(lds, a, l, P, (bf16_t*)(ws + WS_Y), ws, q, pr_); }
#endif
#ifdef PROBE_LRUPREPX2
            for (int q = blockIdx.x; q < 256; q += G) lru_prep_item(lds, a, l, P, (float*)(ws + WS_LH), (float*)(ws + WS_LA), ws, ws, q);
#endif
            PrepRegs cur, nxt;
            if ((int)blockIdx.x < 1024) rwkv_prep_loads(cur, l, P, ws, (int)blockIdx.x);
            for (int q = blockIdx.x; q < 1280; q += G) {
                if (q < 1024) {
                    const int qn = q + G;
                    if (qn < 1024) rwkv_prep_loads(nxt, l, P, ws, qn);
                    rwkv_prep_item(lds, a, l, P, (bf16_t*)(ws + WS_Y), ws, q, cur);
                    if (qn < 1024) cur = nxt;
                } else lru_prep_item(lds, a, l, P, (float*)(ws + WS_LH), (float*)(ws + WS_LA), ws, ws, q - 1024);
            }
        }
#endif
        GRID_SYNC();
#ifndef DIS_P2B
        {
            LAS int* qslot = (LAS int*)(lds + 140 * 1024);
            for (;;) {
                KArgs* a = ARGP(); unsigned char* ws = a->ws;
                const bf16_t* P = (const bf16_t*)(ws + WS_P); bf16_t* Y = (bf16_t*)(ws + WS_Y);
                __syncthreads();
                if (TID == 0) *qslot = (int)atomicAdd((unsigned*)(ws + WS_CTL) + l, 1u);
                __syncthreads();
#ifdef PROBE_ATTX2
                int it = *qslot;
                if (it >= N_ITEMS + 512) break;
                if (it >= N_ITEMS) it -= 512;
#else
                const int it = *qslot;
                if (it >= ((l == 0) ? N_ITEMS + 368 : N_ITEMS)) break;
                if (it >= N_ITEMS) {
                    const int wi = (it - N_ITEMS) * 8 + WAVE;
                    LAS float* scr = (LAS float*)(lds + WAVE * 16384);
                    bf16_t* WIN = (bf16_t*)(ws + WS_WIN); bf16_t* WOUT = (bf16_t*)(ws + WS_WOUT);
                    if (wi < 512) tr_item(a->in[21], DM, nullptr, false, WOUT, DM, scr, wi / 32, wi % 32, LANE);
                    else if (wi < 2432) { const int r = wi - 512; tr_item(a->in[2] + (size_t)DM * NIN, NIN, a->in[1] + DM, true, WIN + (size_t)NP * DM, DM, scr, r / 120, r % 120, LANE); }
                    else { const int r = wi - 2432; tr_item(a->in[21] + (size_t)DM * DM, DM, nullptr, false, WOUT + (size_t)DM * DM, DM, scr, r / 32, r % 32, LANE); }
                    continue;
                }
#endif
                if (it < 8) {
                    rwkv_chain_item(lds, ws, ws, it);
#ifdef PROBE_CHAINX2
                    __syncthreads();
                    rwkv_chain_item(lds, ws, ws, it);
#endif
                }
                else if (it == 8) lru_carry_item((const float*)(ws + WS_LH), (const float*)(ws + WS_LA), (float*)(ws + WS_HIN));
                else {
                    const int aa = it - 9, qb = 31 - (aa >> 4), r = aa & 15, bh = r & 7;
                    const float* Fl = (const float*)(ws + WS_FL); const float* Ftot = (const float*)(ws + WS_FTOT); const float* Kc = (const float*)(ws + WS_KMAX);
                    if (r < 8) attn_unit<1>(lds, P, Y, Fl, Ftot, Kc, bh, qb);
                    else attn_unit<0>(lds, P, Y, Fl, Ftot, Kc, bh, qb);
                }
            }
        }
#endif
        GRID_SYNC();
        {
            KArgs* a = ARGP(); unsigned char* ws = a->ws;
            const bf16_t* P = (const bf16_t*)(ws + WS_P); bf16_t* Y = (bf16_t*)(ws + WS_Y);
            const int lane = LANE, gw = GW, NGW = NGW_;
            for (int it = gw; it < 4096; it += 2 * NGW) { const int it2 = it + NGW; rwkv_out_pair(a, l, P, Y, ws, it, it2 < 4096 ? it2 : -1, lane); }
            for (int q = blockIdx.x; q < 256; q += GRID_N) lru_apply_item(P, Y, (const float*)(ws + WS_LH), (const float*)(ws + WS_LA), (const float*)(ws + WS_HIN), q);
        }
        GRID_SYNC();
#ifndef DIS_P3
        {
            KArgs* a = ARGP(); unsigned char* ws = a->ws;
            pg8::Gemm g{(const bf16_t*)(ws + WS_Y), (const bf16_t*)(ws + WS_WOUT) + (size_t)l * DM * DM, M, DM, DM};
            pg8::StaticOrder S; S.init(M, DM, GRID_N, (int)blockIdx.x);
            EpiOut E{l == 0 ? a->in[0] : (const float*)a->out, l == 0 ? a->out : nullptr, (bf16_t*)(ws + WS_XB), (float*)(ws + WS_ROWSS) + (size_t)(l + 1) * M};
#ifdef PROBE_P3X2
            if (l == 0) { EpiOut E2{a->in[0], a->out, (bf16_t*)(ws + WS_XB), (float*)(ws + WS_HG)}; pg8::gemm_phase<EpiOut, pg8::StaticOrder, true, true>(lds, g, S, E2); __syncthreads(); }
#endif
            pg8::gemm_phase<EpiOut, pg8::StaticOrder, true, true>(lds, g, S, E);
        }
#endif
        GRID_SYNC();
    }
    {
        KArgs* a = ARGP(); unsigned char* ws = a->ws;
        const float* fgm = a->in[22]; float* out = a->out;
        const bf16_t* XB = (const bf16_t*)(ws + WS_XB); const float* rss = (const float*)(ws + WS_ROWSS) + (size_t)DEPTH * M;
        const int lane = LANE, gw = GW, NGW = NGW_;
        for (int m0 = gw; m0 < M; m0 += 4 * NGW) {
            u32x2 v[4][4]; float sq[4];
#pragma unroll
            for (int u = 0; u < 4; ++u) { const int m = m0 + u * NGW; const int mm = (m < M) ? m : m0;
                const u32x2* xr = (const u32x2*)(XB + (size_t)mm * DM) + lane;
#pragma unroll
                for (int j = 0; j < 4; ++j) v[u][j] = xr[64 * j];
                sq[u] = rss[mm]; }
            const f32x4* gr = (const f32x4*)fgm + lane;
            const f32x4 g0 = gr[0], g1 = gr[64], g2 = gr[128], g3 = gr[192];
#pragma unroll
            for (int u = 0; u < 4; ++u) { const int m = m0 + u * NGW; if (m >= M) break;
                const float rs = rsqrtf(sq[u] * (1.f / 1024.f) + 1e-6f);
                f32x4* xw = (f32x4*)(out + (size_t)m * DM) + lane;
                const f32x4 gg[4] = {g0, g1, g2, g3};
#pragma unroll
                for (int j = 0; j < 4; ++j) { const u32x2 p = v[u][j]; f32x4 o = {bflo(p.x), bfhi(p.x), bflo(p.y), bfhi(p.y)}; xw[64 * j] = o * rs * gg[j]; } }
        }
    }
}

extern "C" void kernel_launch(void* const* d_in, const int* in_sizes, int n_in, void* d_out, int out_size, void* d_ws, size_t ws_size, hipStream_t stream) {
    static int grid = 0;
    if (grid == 0) {
        int dev = 0, cus = 0, per_cu = 0;
        hipGetDevice(&dev);
        hipDeviceGetAttribute(&cus, hipDeviceAttributeMultiprocessorCount, dev);
        hipFuncSetAttribute((const void*)mega_fwd, hipFuncAttributeMaxDynamicSharedMemorySize, LDS_BYTES);
        hipOccupancyMaxActiveBlocksPerMultiprocessor(&per_cu, (const void*)mega_fwd, NTHR, LDS_BYTES);
        if (per_cu < 1) per_cu = 1;
        grid = cus * per_cu;
        if (n_in != 23 || ws_size < WS_END) { fprintf(stderr, "kernel_launch: unexpected inputs (n_in %d, ws %zu)\n", n_in, ws_size); }
    }
    (void)hipMemsetAsync(d_ws, 0, 64 * 1024, stream);
    Args a{};
    for (int i = 0; i < 23; ++i) a.in[i] = (const float*)d_in[i];
    a.out = (float*)d_out; a.ws = (unsigned char*)d_ws;
    void* args[] = {&a};
    hipError_t e = hipLaunchCooperativeKernel((const void*)mega_fwd, dim3(grid), dim3(NTHR), args, LDS_BYTES, stream);
    if (e != hipSuccess) fprintf(stderr, "cooperative launch failed: %s (grid %d)\n", hipGetErrorString(e), grid);
}
```

```cpp
#include <hip/hip_runtime.h>
#include <hip/hip_cooperative_groups.h>
#include <cstdio>
#include <cstdint>
namespace cg = cooperative_groups;
namespace pg8 {
#define PG8_LAS __attribute__((address_space(3)))
typedef unsigned short bf16_t;
typedef short bf16x8 __attribute__((ext_vector_type(8)));
typedef float f32x4 __attribute__((ext_vector_type(4)));
typedef unsigned u32x4 __attribute__((ext_vector_type(4)));
constexpr int BM = 256, BK = 64, HALF = 128, HTB = HALF * BK * 2  , STAGE_BYTES = 8 * HTB, NXCD = 8, WGM = 8;

__host__ __device__ __forceinline__ int lds_byte(int r, int c) { const int st = (r >> 4) * 2 + (c >> 5), rr = r & 15, cc = c & 31, ob = rr * 64 + cc * 2; return st * 1024 + (ob ^ (((ob >> 9) & 1) << 5)); }
__host__ __device__ __forceinline__ void stage_rc(int b, int& R, int& C) { const int st = b / 1024, sb = b % 1024, swz = sb ^ (((sb >> 9) & 1) << 5); R = (st >> 1) * 16 + swz / 64; C = (st & 1) * 32 + (swz % 64) / 2; }
__host__ __device__ __forceinline__ int perm32(int rho) { const int n = rho >> 4, i = rho & 15; return 8 * (i >> 2) + 4 * n + (i & 3); }

struct Unit { int pm, pn; };
struct Gemm { const bf16_t* A; const bf16_t* Bt; int M, N, K; };

struct StaticOrder {
    int nM, nN, nwg, G, c;
    __host__ __device__ void init(int M, int N, int G_, int c_) { nM = M / BM; nN = N / BM; nwg = nM * nN; G = G_; c = c_; }
    __host__ __device__ bool next(int i, Unit& u) const {
        const long L = (long)i * G + c; if (L >= nwg) return false;
        int wgid = (int)L; { const int q = nwg / NXCD, r = nwg % NXCD, xcd = wgid % NXCD, off = wgid / NXCD; wgid = (xcd < r ? xcd * (q + 1) : r * (q + 1) + (xcd - r) * q) + off; }
        const int nig = WGM * nN, gid = wgid / nig, fm = gid * WGM, gsz = (nM - fm) < WGM ? (nM - fm) : WGM;
        u.pm = fm + ((wgid % nig) % gsz); u.pn = (wgid % nig) / gsz; return true;
    }
    __device__ __forceinline__ void a_ready(const Unit&) const {}
    __device__ __forceinline__ void done(const Unit&) const {}
};

__device__ __forceinline__ unsigned cvt_pk_bf16(float lo, float hi) { unsigned r; asm volatile("v_cvt_pk_bf16_f32 %0, %1, %2" : "=v"(r) : "v"(lo), "v"(hi)); return r; }

template <class Epi, class Sched, bool ALIGN_EPI = false, bool SP2 = false>
__device__ __forceinline__ void gemm_phase(PG8_LAS unsigned char* lds, const Gemm g, const Sched& S, const Epi& E) {
    int tid_ = threadIdx.x; asm volatile("" : "+v"(tid_)); const int tid = tid_, wid = __builtin_amdgcn_readfirstlane(tid >> 6), lane = tid & 63, wr = wid >> 2, wc = wid & 3, fr = lane & 15, fq = lane >> 4;
    const int K = g.K, nt = K / BK;
    unsigned voffA[2], voffB[2];
#pragma unroll
    for (int i = 0; i < 2; ++i) { int R, C; stage_rc(tid * 16 + i * 8192, R, C); const int Rb = Epi::PERM ? ((R & ~31) + perm32(R & 31)) : R;
        voffA[i] = (unsigned)(R * K + C) * 2u; voffB[i] = (unsigned)(Rb * K + C) * 2u; }
    const size_t kstep = (size_t)(BK * 2);
    const size_t hstep = (size_t)HALF * K * 2;
    const size_t tstep = 2 * hstep;
    const unsigned ldsw = (unsigned)wid * 1024u;
    const int aoff = lds_byte(wr * 64 + fr, fq * 8), boff = lds_byte(wc * 32 + fr, fq * 8);
#define PG8_SA(b, h) (((b) * 2 + (h)) * HTB)
#define PG8_SB(b, h) ((4 + (b) * 2 + (h)) * HTB)
#define PG8_STAGE(bufoff, gbase, voff) do { _Pragma("unroll") for (int _i = 0; _i < 2; ++_i) \
        __builtin_amdgcn_global_load_lds((const unsigned*)((const char*)(gbase) + (voff)[_i]), (PG8_LAS unsigned*)(lds + (bufoff) + ldsw + _i * 8192), 16, 0, 0); } while (0)
#define PG8_LDA(dst, b, h) do { _Pragma("unroll") for (int m = 0; m < 4; ++m) _Pragma("unroll") for (int k = 0; k < 2; ++k) dst[m][k] = *(const PG8_LAS bf16x8*)(lds + PG8_SA(b, h) + aoff + m * 2048 + k * 1024); } while (0)
#define PG8_LDB(dst, b, h) do { _Pragma("unroll") for (int n = 0; n < 2; ++n) _Pragma("unroll") for (int k = 0; k < 2; ++k) dst[n][k] = *(const PG8_LAS bf16x8*)(lds + PG8_SB(b, h) + boff + n * 2048 + k * 1024); } while (0)
#define PG8_MMA(ai, bj, At, Bt) do { __builtin_amdgcn_s_setprio(1); _Pragma("unroll") for (int m = 0; m < 4; ++m) _Pragma("unroll") for (int n = 0; n < 2; ++n) _Pragma("unroll") for (int k = 0; k < 2; ++k) \
        acc[ai][bj][m][n] = __builtin_amdgcn_mfma_f32_16x16x32_bf16(Bt[n][k], At[m][k], acc[ai][bj][m][n], 0, 0, 0); __builtin_amdgcn_s_setprio(0); } while (0)
#define PG8_WAIT_V(n) asm volatile("s_waitcnt vmcnt(" #n ")" ::: "memory")
#define PG8_WAIT_L(n) asm volatile("s_waitcnt lgkmcnt(" #n ")" ::: "memory")
#define PG8_BAR __builtin_amdgcn_s_barrier()
#define PG8_SCHED __builtin_amdgcn_sched_barrier(0)
    Unit cur, nxt; int ui = 0;
    if (!S.next(0, cur)) return;
    f32x4 acc[2][2][4][2];
#pragma unroll
    for (int a = 0; a < 2; ++a)
#pragma unroll
        for (int b = 0; b < 2; ++b)
#pragma unroll
            for (int m = 0; m < 4; ++m)
#pragma unroll
                for (int n = 0; n < 2; ++n) acc[a][b][m][n] = (f32x4){0.f, 0.f, 0.f, 0.f};
    bf16x8 At[4][2], B0[2][2], B1[2][2];
    const char* cA = (const char*)g.A + (size_t)cur.pm * tstep; const char* cB = (const char*)g.Bt + (size_t)cur.pn * tstep;
    S.a_ready(cur);
    if constexpr (SP2) {
        PG8_STAGE(PG8_SB(0, 0), cB, voffB); PG8_STAGE(PG8_SB(0, 1), cB + hstep, voffB); PG8_STAGE(PG8_SA(0, 0), cA, voffA); PG8_STAGE(PG8_SA(0, 1), cA + hstep, voffA);
        if (wr == 1) PG8_BAR;
        PG8_WAIT_V(2); PG8_BAR;
        PG8_STAGE(PG8_SB(1, 0), cB + kstep, voffB); PG8_STAGE(PG8_SA(1, 0), cA + kstep, voffA); PG8_STAGE(PG8_SB(1, 1), cB + hstep + kstep, voffB);
        PG8_WAIT_V(6); PG8_BAR;
    } else {
        PG8_STAGE(PG8_SB(0, 0), cB, voffB); PG8_STAGE(PG8_SA(0, 0), cA, voffA); PG8_STAGE(PG8_SB(0, 1), cB + hstep, voffB); PG8_STAGE(PG8_SA(0, 1), cA + hstep, voffA);
        if (wr == 1) PG8_BAR;
        PG8_WAIT_V(4); PG8_BAR;
        PG8_STAGE(PG8_SB(1, 0), cB + kstep, voffB); PG8_STAGE(PG8_SA(1, 0), cA + kstep, voffA); PG8_STAGE(PG8_SB(1, 1), cB + hstep + kstep, voffB);
        PG8_WAIT_V(6); PG8_BAR;
    }
    for (;;) {
        const bool has_next = S.next(ui + 1, nxt);
        const char* nA = has_next ? (const char*)g.A + (size_t)nxt.pm * tstep : cA; const char* nB = has_next ? (const char*)g.Bt + (size_t)nxt.pn * tstep : cB;
        for (int t = 0; t < nt; t += 2) {
            const bool last = (t == nt - 2);
            const char* a1 = cA + (size_t)(t + 1) * kstep;
            const char* a2 = last ? nA : cA + (size_t)(t + 2) * kstep; const char* b2 = last ? nB : cB + (size_t)(t + 2) * kstep;
            const char* a3 = a2 + kstep; const char* b3 = b2 + kstep;
            if (last && has_next) S.a_ready(nxt);
            if constexpr (SP2) {
            PG8_LDB(B0, 0, 0); PG8_LDB(B1, 0, 1); PG8_SCHED; PG8_LDA(At, 0, 0); PG8_STAGE(PG8_SA(1, 1), a1 + hstep, voffA);
            PG8_WAIT_V(8); PG8_WAIT_L(0); PG8_BAR; PG8_MMA(0, 0, At, B0); PG8_MMA(0, 1, At, B1); PG8_BAR; PG8_SCHED;
            PG8_LDA(At, 0, 1); PG8_STAGE(PG8_SB(0, 0), b2, voffB); PG8_STAGE(PG8_SB(0, 1), b2 + hstep, voffB); PG8_STAGE(PG8_SA(0, 0), a2, voffA);
            PG8_WAIT_V(8); PG8_WAIT_L(0); PG8_BAR; PG8_MMA(1, 0, At, B0); PG8_MMA(1, 1, At, B1); PG8_BAR; PG8_SCHED;
            PG8_LDB(B0, 1, 0); PG8_LDB(B1, 1, 1); PG8_SCHED; PG8_LDA(At, 1, 0); PG8_STAGE(PG8_SA(0, 1), a2 + hstep, voffA);
            PG8_WAIT_V(8); PG8_WAIT_L(0); PG8_BAR; PG8_MMA(0, 0, At, B0); PG8_MMA(0, 1, At, B1); PG8_BAR; PG8_SCHED;
            PG8_LDA(At, 1, 1); PG8_STAGE(PG8_SB(1, 0), b3, voffB); PG8_STAGE(PG8_SB(1, 1), b3 + hstep, voffB); PG8_STAGE(PG8_SA(1, 0), a3, voffA);
            PG8_WAIT_V(8); PG8_WAIT_L(0); PG8_BAR; PG8_MMA(1, 0, At, B0); PG8_MMA(1, 1, At, B1); PG8_BAR; PG8_SCHED;
            } else {
            PG8_LDB(B0, 0, 0); PG8_SCHED; PG8_LDA(At, 0, 0); PG8_STAGE(PG8_SA(1, 1), a1 + hstep, voffA);
            PG8_WAIT_L(8); PG8_BAR; PG8_WAIT_L(0); PG8_MMA(0, 0, At, B0); PG8_BAR; PG8_SCHED;
            PG8_LDB(B1, 0, 1); PG8_STAGE(PG8_SB(0, 0), b2, voffB);
            PG8_BAR; PG8_WAIT_L(0); PG8_MMA(0, 1, At, B1); PG8_BAR;
            PG8_LDA(At, 0, 1); PG8_STAGE(PG8_SA(0, 0), a2, voffA);
            PG8_BAR; PG8_WAIT_L(0); PG8_MMA(1, 0, At, B0); PG8_BAR; PG8_SCHED;
            PG8_STAGE(PG8_SB(0, 1), b2 + hstep, voffB);
            PG8_WAIT_V(6); PG8_BAR; PG8_MMA(1, 1, At, B1); PG8_BAR;
            PG8_LDB(B0, 1, 0); PG8_SCHED; PG8_LDA(At, 1, 0); PG8_STAGE(PG8_SA(0, 1), a2 + hstep, voffA);
            PG8_WAIT_L(8); PG8_BAR; PG8_WAIT_L(0); PG8_MMA(0, 0, At, B0); PG8_BAR; PG8_SCHED;
            PG8_LDB(B1, 1, 1); PG8_STAGE(PG8_SB(1, 0), b3, voffB);
            PG8_BAR; PG8_WAIT_L(0); PG8_MMA(0, 1, At, B1); PG8_BAR;
            PG8_LDA(At, 1, 1); PG8_STAGE(PG8_SA(1, 0), a3, voffA);
            PG8_BAR; PG8_WAIT_L(0); PG8_MMA(1, 0, At, B0); PG8_BAR; PG8_SCHED;
            PG8_STAGE(PG8_SB(1, 1), b3 + hstep, voffB);
            PG8_WAIT_V(6); PG8_BAR; PG8_MMA(1, 1, At, B1); PG8_BAR;
            }
        }
        if constexpr (ALIGN_EPI) { if (wr == 0) PG8_BAR; }
        if constexpr (!Epi::AFTER_DRAIN) { E(acc, cur, wr, wc, fr, fq); S.done(cur); }
        if (!has_next) break;
#pragma unroll
        for (int a = 0; a < 2; ++a)
#pragma unroll
            for (int b = 0; b < 2; ++b)
#pragma unroll
                for (int m = 0; m < 4; ++m)
#pragma unroll
                    for (int n = 0; n < 2; ++n) acc[a][b][m][n] = (f32x4){0.f, 0.f, 0.f, 0.f};
        cur = nxt; cA = nA; cB = nB; ++ui;
        if constexpr (ALIGN_EPI) { if (wr == 1) PG8_BAR; }
    }
    PG8_WAIT_V(0);
    if constexpr (!ALIGN_EPI) { if (wr == 0) PG8_BAR; }
    PG8_BAR;
    if constexpr (Epi::AFTER_DRAIN) { E.fused(acc, cur, wr, wc, fr, fq, lds, wid, lane); S.done(cur); }
#undef PG8_SA
#undef PG8_SB
#undef PG8_STAGE
#undef PG8_LDA
#undef PG8_LDB
#undef PG8_MMA
#undef PG8_WAIT_V
#undef PG8_WAIT_L
#undef PG8_BAR
#undef PG8_SCHED
}
}

#define LAS __attribute__((address_space(3)))
#ifndef USE_CG_SYNC
#define USE_CG_SYNC 0
#endif
typedef unsigned short bf16_t;
typedef short bf16x8 __attribute__((ext_vector_type(8)));
typedef float f32x4 __attribute__((ext_vector_type(4)));
typedef float f32x16 __attribute__((ext_vector_type(16)));
typedef unsigned u32x4 __attribute__((ext_vector_type(4)));
typedef unsigned u32x2 __attribute__((ext_vector_type(2)));
typedef float f32x2_t __attribute__((ext_vector_type(2)));
typedef __bf16 bf16x2_t __attribute__((ext_vector_type(2)));

constexpr int BATCH = 2, SEQ = 8192, DM = 1024, M = BATCH * SEQ, NHEAD = 4, DEPTH = 2;
constexpr int NIN = 3652, NP = 3840;
constexpr int T_FQ = 0, T_SQ = 4, T_RR = 8, T_RK = 9, T_RV = 10, T_RG = 11, T_LX = 12, T_LG = 13, T_MISC = 14;
constexpr float LOG2E = 1.4426950408889634f;
constexpr float C2 = 0.125f * LOG2E;
constexpr int LDS_BYTES = 147456;
constexpr int NTHR = 512;

constexpr size_t MiB = 1u << 20;
constexpr size_t WS_CTL = 0, WS_ROWSS = 64 * 1024, WS_FL = 256 * 1024, WS_BAR = 16 * 1024, WS_FTOT = 512 * 1024, WS_KMAX = 640 * 1024, WS_HIN = 704 * 1024, WS_LORA = 960 * 1024;
constexpr size_t WS_WIN = 1 * MiB, WS_WOUT = 16 * MiB, WS_XB = 20 * MiB, WS_Y = 52 * MiB, WS_P = 84 * MiB, WS_LH = 204 * MiB, WS_LA = 220 * MiB, WS_END = 253 * MiB;

struct Args { const float* in[23]; float* out; unsigned char* ws; };
typedef const __attribute__((address_space(4))) Args KArgs;
#define ARGP() ({ KArgs* p_ = (KArgs*)__builtin_amdgcn_kernarg_segment_ptr(); asm volatile("" : "+s"(p_)); p_; })

__device__ __forceinline__ float bf2f(bf16_t v) { return __builtin_bit_cast(float, (unsigned)v << 16); }
__device__ __forceinline__ float bflo(unsigned v) { return __builtin_bit_cast(float, v << 16); }
__device__ __forceinline__ float bfhi(unsigned v) { return __builtin_bit_cast(float, v & 0xffff0000u); }
__device__ __forceinline__ unsigned cvtpk(float lo, float hi) { f32x2_t v = {lo, hi}; bf16x2_t b = __builtin_convertvector(v, bf16x2_t); return __builtin_bit_cast(unsigned, b); }
__device__ __forceinline__ float wave_sum(float v) {
#pragma unroll
    for (int o = 1; o < 64; o <<= 1) v += __shfl_xor(v, o);
    return v;
}
__device__ __forceinline__ float sigm(float x) { return __builtin_amdgcn_rcpf(1.f + __expf(-x)); }
__device__ __forceinline__ float softplus_(float x) { return fmaxf(x, 0.f) + __logf(1.f + __expf(-fabsf(x))); }
__device__ __forceinline__ float tanh_(float x) { const float e = __expf(-2.f * fabsf(x)); const float t = (1.f - e) * __builtin_amdgcn_rcpf(1.f + e); return x < 0.f ? -t : t; }
__device__ __forceinline__ float ex2(float x) { return __builtin_amdgcn_exp2f(x); }
template <int CTRL> __device__ __forceinline__ float dpp_f(float x) { return __builtin_bit_cast(float, __builtin_amdgcn_update_dpp(0, __builtin_bit_cast(int, x), CTRL, 0xf, 0xf, true)); }
__device__ __forceinline__ float red8(float x) { x += dpp_f<0xB1>(x); x += dpp_f<0x4E>(x); x += dpp_f<0x141>(x); return x; }
__device__ __forceinline__ int tid_fresh() { int t = threadIdx.x; asm volatile("" : "+v"(t)); return t; }
#define LDS_WAIT() asm volatile("s_waitcnt lgkmcnt(0)" ::: "memory")
#define BAR_LDS() asm volatile("s_waitcnt lgkmcnt(0)\n\ts_barrier" ::: "memory")

__device__ __forceinline__ int orig_col(int n) {
    const int t = n >> 8, c = n & 255;
    if (t < 4) return n;
    if (t < 8) return 1028 + (t - 4) * 256 + c;
    if (t < 11) return 2052 + (t - 8) * 256 + c;
    if (t < 14) return 2884 + (t - 11) * 256 + c;
    if (c < 64) return 2820 + c;
    if (c < 68) return 1024 + (c - 64);
    return -1;
}

struct EpiIn {
    static constexpr bool PERM = true, AFTER_DRAIN = false;
    bf16_t* P; const float* rowss;
    __device__ __forceinline__ void operator()(const pg8::f32x4 (&acc)[2][2][4][2], const pg8::Unit& u, int wr, int wc, int fr, int fq) const {
        const int row0 = u.pm * 256 + wr * 64 + fr, col0 = u.pn * 256 + wc * 32 + 8 * fq;
        float rsv[8];
#pragma unroll
        for (int i = 0; i < 8; ++i) rsv[i] = rowss[row0 + (i >> 2) * 128 + (i & 3) * 16];
#pragma unroll
        for (int ai = 0; ai < 2; ++ai)
#pragma unroll
            for (int m = 0; m < 4; ++m) {
                const int row = row0 + ai * 128 + m * 16;
                const float rs = rsqrtf(rsv[ai * 4 + m] * (1.f / 1024.f) + 1e-6f);
                bf16_t* rp = P + (size_t)row * NP + col0;
#pragma unroll
                for (int bj = 0; bj < 2; ++bj) {
                    const f32x4 v0 = acc[ai][bj][m][0] * rs, v1 = acc[ai][bj][m][1] * rs;
                    u32x4 w; w.x = cvtpk(v0[0], v0[1]); w.y = cvtpk(v0[2], v0[3]); w.z = cvtpk(v1[0], v1[1]); w.w = cvtpk(v1[2], v1[3]);
                    *(u32x4*)(rp + bj * 128) = w;
                }
            }
    }
};
struct EpiOut {
    static constexpr bool PERM = true, AFTER_DRAIN = false;
    const float* xin; float* xout; bf16_t* xb; float* rss;
    __device__ __forceinline__ void operator()(const pg8::f32x4 (&acc)[2][2][4][2], const pg8::Unit& u, int wr, int wc, int fr, int fq) const {
        const int row0 = u.pm * 256 + wr * 64 + fr, col0 = u.pn * 256 + wc * 32 + 8 * fq;
#pragma unroll
        for (int am = 0; am < 8; ++am) {
            const int ai = am >> 2, m = am & 3;
            const int row = row0 + ai * 128 + m * 16;
            f32x4 xr[2][2];
#pragma unroll
            for (int bj = 0; bj < 2; ++bj) { const size_t off = (size_t)row * DM + col0 + bj * 128; xr[bj][0] = *(const f32x4*)(xin + off); xr[bj][1] = *(const f32x4*)(xin + off + 4); }
            float ss = 0.f;
#pragma unroll
            for (int bj = 0; bj < 2; ++bj) {
                const size_t off = (size_t)row * DM + col0 + bj * 128;
                const f32x4 v0 = acc[ai][bj][m][0] + xr[bj][0], v1 = acc[ai][bj][m][1] + xr[bj][1];
                if (xout) { *(f32x4*)(xout + off) = v0; *(f32x4*)(xout + off + 4) = v1; }
                u32x4 w; w.x = cvtpk(v0[0], v0[1]); w.y = cvtpk(v0[2], v0[3]); w.z = cvtpk(v1[0], v1[1]); w.w = cvtpk(v1[2], v1[3]);
                *(u32x4*)(xb + off) = w;
                ss += (v0[0] * v0[0] + v0[1] * v0[1]) + (v0[2] * v0[2] + v0[3] * v0[3]) + (v1[0] * v1[0] + v1[1] * v1[1]) + (v1[2] * v1[2] + v1[3] * v1[3]);
            }
            ss += __shfl_xor(ss, 16); ss += __shfl_xor(ss, 32); if (fq == 0) atomicAdd(rss + row, ss);
        }
    }
};

__device__ __forceinline__ void tr_item(const float* W, int ldw, const float* gk, bool permute, bf16_t* WT, int K, LAS float* scr, int kb, int nb, int lane) {
    const int k0 = 64 * kb, n0 = 32 * nb;
    const int n = n0 + (lane & 31);
    const int oc = permute ? orig_col(n) : n;
#pragma unroll
    for (int i = 0; i < 32; ++i) {
        const int kk = 2 * i + (lane >> 5);
        float v = (oc >= 0) ? W[(size_t)(k0 + kk) * ldw + oc] : 0.f;
        if (gk) v *= gk[k0 + kk];
        scr[kk * 33 + (lane & 31)] = v;
    }
    LDS_WAIT();
    const int c = lane & 7;
#pragma unroll
    for (int j = 0; j < 4; ++j) {
        const int nn = (lane >> 3) + 8 * j; const LAS float* s = scr + (8 * c) * 33 + nn;
        u32x4 o; o.x = cvtpk(s[0 * 33], s[1 * 33]); o.y = cvtpk(s[2 * 33], s[3 * 33]); o.z = cvtpk(s[4 * 33], s[5 * 33]); o.w = cvtpk(s[6 * 33], s[7 * 33]);
        *(u32x4*)(WT + (size_t)(n0 + nn) * K + k0 + 8 * c) = o;
    }
    LDS_WAIT();
}

typedef short s16x4_t __attribute__((ext_vector_type(4)));
__device__ __forceinline__ s16x4_t vtr16(const LAS unsigned char* p) { return __builtin_amdgcn_ds_read_tr16_b64_v4i16((LAS s16x4_t*)p); }
__device__ __forceinline__ int kpos(int key) { return (key & 48) | ((key & 4) << 1) | ((key & 8) >> 1) | (key & 3); }
__device__ __forceinline__ bf16x8 pack8(float a, float b, float c, float d, float e, float f, float g, float h) {
    u32x4 w; w.x = cvtpk(a, b); w.y = cvtpk(c, d); w.z = cvtpk(e, f); w.w = cvtpk(g, h); return __builtin_bit_cast(bf16x8, w);
}

template <int MODE>
__device__ __forceinline__ void attn_unit(LAS unsigned char* lds, const bf16_t* P, bf16_t* Y, const float* Fl, const float* Ftot, const float* Kc, int bh, int qb) {
    constexpr int QT = (MODE == 0) ? T_FQ : T_SQ, KT = QT + 1, VT = QT + 2, GT = QT + 3;
    constexpr int KP = 144, KBUF = 64 * KP;
    constexpr int O_K = 0, O_V = 2 * KBUF, O_F = 4 * KBUF, O_FOFF = O_F + 512;
    const int tid = tid_fresh(), lane = tid & 63, r32 = lane & 31, hi = lane >> 5;
    const int wid = __builtin_amdgcn_readfirstlane(tid >> 6);
    const int b = bh >> 2, h = bh & 3;
    const size_t rowbase = (size_t)b * SEQ;
    const int qw0 = qb * 256 + wid * 32;
    const int qg = qw0 + r32;
    LAS float* foff = (LAS float*)(lds + O_FOFF);
    LAS float* Lkpm = (LAS float*)(lds + O_FOFF + 128);
    LAS int* Lalive = (LAS int*)(lds + O_FOFF + 256);
    bf16x8 qr[4];
    {
        const bf16_t* qp = P + (rowbase + qg) * NP + QT * 256 + h * 64 + hi * 8;
#pragma unroll
        for (int st = 0; st < 4; ++st) qr[st] = *(const bf16x8*)(qp + st * 16);
    }
    float Fq = 0.f, qnC = 0.f;
    if (MODE == 0) {
        Fq = Fl[(size_t)bh * SEQ + qg];
        float q2 = 0.f;
#pragma unroll
        for (int st = 0; st < 4; ++st)
#pragma unroll
            for (int e = 0; e < 8; ++e) { const float qv = bf2f((bf16_t)qr[st][e]); q2 += qv * qv; }
        q2 += __shfl_xor(q2, 32);
        qnC = sqrtf(q2) * C2;
    }
    bool done = false;
    const int skey = tid >> 3, sch = tid & 7;
    const bf16_t* kg = P + (rowbase + skey) * NP + KT * 256 + h * 64 + sch * 8;
    const bf16_t* vg = P + (rowbase + skey) * NP + VT * 256 + h * 64 + sch * 8;
    const float* fg = Fl + (size_t)bh * SEQ + (tid & 63);
    const int kwoff = O_K + skey * KP + sch * 16;
    const int vwoff = O_V + skey * KP + sch * 16;
    u32x4 kA, vA, kB, vB; float fA = 0.f, fB = 0.f;
#define LOAD_TILE(KS, VS, FS, jj) do { KS = *(const u32x4*)(kg + (size_t)(jj) * 64 * NP); VS = *(const u32x4*)(vg + (size_t)(jj) * 64 * NP); if (MODE == 0 && tid < 64) FS = fg[(jj) * 64]; } while (0)
#define STORE_TILE(KS, VS, FS, bufi) do { *(LAS u32x4*)(lds + (bufi) * KBUF + kwoff) = KS; \
        *(LAS u32x4*)(lds + (bufi) * KBUF + vwoff) = VS; \
        if (MODE == 0 && tid < 64) ((LAS float*)(lds + O_F + (bufi) * 256))[tid] = FS; } while (0)
    float m_run = -INFINITY, l_run = 0.f, R = 1.f;
    f32x16 o0, o1;
#pragma unroll
    for (int r = 0; r < 16; ++r) { o0[r] = 0.f; o1[r] = 0.f; }
    const int jd = 4 * qb + 3;
    u32x4 kC, vC; float fC = 0.f;
    LOAD_TILE(kC, vC, fC, jd); LOAD_TILE(kA, vA, fA, jd - 1); LOAD_TILE(kB, vB, fB, jd - 2);
    if (MODE == 0) {
        if (wid == 0) {
            const float ft = (lane < 32) ? Ftot[bh * 32 + lane] : 0.f;
            float inc = ft, km = (lane < 32) ? Kc[bh * 32 + lane] : 0.f;
#pragma unroll
            for (int o = 1; o < 32; o <<= 1) { const float n1 = __shfl_up(inc, o), n2 = __shfl_up(km, o); if (lane >= o) { inc += n1; km = fmaxf(km, n2); } }
            const float excl = inc - ft;
            const float offq = __shfl(excl, qb);
            if (lane < 32) { foff[lane] = excl - offq; Lkpm[lane] = sqrtf(km); }
        }
    }
    STORE_TILE(kC, vC, fC, 0);
    BAR_LDS();
#define ATT_ITER(KS, VS, FS) do { \
        const int buf = it & 1; \
        if (j >= 1) { STORE_TILE(KS, VS, FS, buf ^ 1); if (j >= 3) LOAD_TILE(KS, VS, FS, j - 3); } \
        bool walive = true; \
        if (64 * j <= qw0 + 31 && !done) { \
            const LAS unsigned char* kb = lds + O_K + buf * KBUF + r32 * KP + hi * 16; \
            f32x16 p0, p1; \
        _Pragma("unroll") \
            for (int r = 0; r < 16; ++r) { p0[r] = 0.f; p1[r] = 0.f; } \
        _Pragma("unroll") \
            for (int st = 0; st < 4; ++st) { \
                const bf16x8 a0 = *(const LAS bf16x8*)(kb + st * 32); \
                const bf16x8 a1 = *(const LAS bf16x8*)(kb + 32 * KP + st * 32); \
                p0 = __builtin_amdgcn_mfma_f32_32x32x16_bf16(a0, qr[st], p0, 0, 0, 0); \
                p1 = __builtin_amdgcn_mfma_f32_32x32x16_bf16(a1, qr[st], p1, 0, 0, 0); \
            } \
            if (MODE == 0) { \
                const LAS float* fs = (const LAS float*)(lds + O_F + buf * 256); \
                const float fq = Fq - foff[j >> 2]; \
                const bool band = (64 * j + 63 > qw0); \
                float mx = -INFINITY; \
        _Pragma("unroll") \
                for (int g = 0; g < 4; ++g) { \
                    const f32x4 f0 = *(const LAS f32x4*)(fs + 8 * g + 4 * hi); \
                    const f32x4 f1 = *(const LAS f32x4*)(fs + 32 + 8 * g + 4 * hi); \
        _Pragma("unroll") \
                    for (int e = 0; e < 4; ++e) { \
                        const int r = 4 * g + e; \
                        float z0 = p0[r] * C2 + (fq - f0[e]); \
                        float z1 = p1[r] * C2 + (fq - f1[e]); \
                        if (band) { const int k0 = 64 * j + 8 * g + 4 * hi + e; if (k0 > qg) z0 = -INFINITY; if (k0 + 32 > qg) z1 = -INFINITY; } \
                        p0[r] = z0; p1[r] = z1; mx = fmaxf(mx, fmaxf(z0, z1)); \
                    } \
                } \
                mx = fmaxf(mx, __shfl_xor(mx, 32)); \
                const float m_new = fmaxf(m_run, mx); \
                const float ms = (m_new == -INFINITY) ? 0.f : m_new; \
                const float alpha = ex2(m_run - ms); \
                float ls = 0.f; \
        _Pragma("unroll") \
                for (int r = 0; r < 16; ++r) { p0[r] = ex2(p0[r] - ms); p1[r] = ex2(p1[r] - ms); ls += p0[r] + p1[r]; } \
                l_run = l_run * alpha + ls; m_run = m_new; \
        _Pragma("unroll") \
                for (int r = 0; r < 16; ++r) { o0[r] *= alpha; o1[r] *= alpha; } \
                const float bound = qnC * Lkpm[(j > 0) ? ((j - 1) >> 2) : 0] + (fq - fs[0]); \
                walive = __builtin_amdgcn_ballot_w64(!(bound < m_run - 30.f)) != 0ull; \
            } else { \
                const bool band = (64 * j + 63 >= qw0); \
                f32x16 k0v, k1v; \
        _Pragma("unroll") \
                for (int r = 0; r < 16; ++r) { \
                    const float e0 = ex2(p0[r] * C2), e1 = ex2(p1[r] * C2); \
                    float kk0 = __builtin_amdgcn_rcpf(1.f + e0), kk1 = __builtin_amdgcn_rcpf(1.f + e1); \
                    float b0 = 1.f - kk0, b1 = 1.f - kk1; \
                    if (band) { const int key = 64 * j + (r & 3) + 8 * (r >> 2) + 4 * hi; if (key >= qg) { kk0 = 1.f; b0 = 0.f; } if (key + 32 >= qg) { kk1 = 1.f; b1 = 0.f; } } \
                    k0v[r] = kk0; k1v[r] = kk1; p0[r] = b0; p1[r] = b1; \
                } \
                float gp[8], og[8], E[8]; \
        _Pragma("unroll") \
                for (int k = 0; k < 4; ++k) { \
                    gp[k] = (k0v[4 * k] * k0v[4 * k + 1]) * (k0v[4 * k + 2] * k0v[4 * k + 3]); \
                    gp[4 + k] = (k1v[4 * k] * k1v[4 * k + 1]) * (k1v[4 * k + 2] * k1v[4 * k + 3]); \
                } \
        _Pragma("unroll") \
                for (int k = 0; k < 8; ++k) og[k] = __shfl_xor(gp[k], 32); \
                float SP = 1.f; \
        _Pragma("unroll") \
                for (int k = 7; k >= 0; --k) { E[k] = SP * (hi == 0 ? og[k] : 1.f); SP *= gp[k] * og[k]; } \
        _Pragma("unroll") \
                for (int k = 0; k < 4; ++k) { \
                    float w = R * E[k]; \
                    p0[4 * k + 3] *= w; w *= k0v[4 * k + 3]; p0[4 * k + 2] *= w; w *= k0v[4 * k + 2]; p0[4 * k + 1] *= w; w *= k0v[4 * k + 1]; p0[4 * k] *= w; \
                    float w1 = R * E[4 + k]; \
                    p1[4 * k + 3] *= w1; w1 *= k1v[4 * k + 3]; p1[4 * k + 2] *= w1; w1 *= k1v[4 * k + 2]; p1[4 * k + 1] *= w1; w1 *= k1v[4 * k + 1]; p1[4 * k] *= w1; \
                } \
                R *= SP; \
                walive = __builtin_amdgcn_ballot_w64(R > 1e-9f) != 0ull; \
            } \
            bf16x8 pa[4]; \
            pa[0] = pack8(p0[0], p0[1], p0[2], p0[3], p0[4], p0[5], p0[6], p0[7]); \
            pa[1] = pack8(p0[8], p0[9], p0[10], p0[11], p0[12], p0[13], p0[14], p0[15]); \
            pa[2] = pack8(p1[0], p1[1], p1[2], p1[3], p1[4], p1[5], p1[6], p1[7]); \
            pa[3] = pack8(p1[8], p1[9], p1[10], p1[11], p1[12], p1[13], p1[14], p1[15]); \
            const LAS unsigned char* vb = lds + O_V + buf * KBUF + (4 * hi + ((lane & 15) >> 2)) * KP + (16 * ((lane >> 4) & 1) + 4 * (lane & 3)) * 2; \
        _Pragma("unroll") \
            for (int ks = 0; ks < 4; ++ks) { \
                const s16x4_t l0_ = vtr16(vb + ks * 16 * KP), h0_ = vtr16(vb + ks * 16 * KP + 8 * KP); \
                const s16x4_t l1_ = vtr16(vb + ks * 16 * KP + 64), h1_ = vtr16(vb + ks * 16 * KP + 8 * KP + 64); \
                const bf16x8 v0 = {l0_[0], l0_[1], l0_[2], l0_[3], h0_[0], h0_[1], h0_[2], h0_[3]}; \
                const bf16x8 v1 = {l1_[0], l1_[1], l1_[2], l1_[3], h1_[0], h1_[1], h1_[2], h1_[3]}; \
                o0 = __builtin_amdgcn_mfma_f32_32x32x16_bf16(v0, pa[ks], o0, 0, 0, 0); \
                o1 = __builtin_amdgcn_mfma_f32_32x32x16_bf16(v1, pa[ks], o1, 0, 0, 0); \
            } \
            if (!walive) done = true; \
        } \
        if (done) walive = false; \
        if (lane == 0) Lalive[(it & 1) * 8 + wid] = walive ? 1 : 0; \
        BAR_LDS(); \
        { \
            const LAS int* av = Lalive + (it & 1) * 8; \
            const int any = (av[0] | av[1]) | (av[2] | av[3]) | (av[4] | av[5]) | (av[6] | av[7]); \
            if (!any) stop_ = true; \
        } \
    } while (0)
    {
        int j = jd, it = 0; bool stop_ = false;
        for (;;) {
            ATT_ITER(kA, vA, fA); --j; ++it; if (stop_ || j < 0) break;
            ATT_ITER(kB, vB, fB); --j; ++it; if (stop_ || j < 0) break;
        }
    }
#undef ATT_ITER
#undef LOAD_TILE
#undef STORE_TILE
    float inv = 1.f;
    if (MODE == 0) { const float lt = l_run + __shfl_xor(l_run, 32); inv = 1.f / lt; }
    const bf16_t* gpt = P + (rowbase + qg) * NP + GT * 256 + h * 64;
    LAS unsigned char* stg = lds + wid * 4608;
#pragma unroll
    for (int g = 0; g < 4; ++g) {
        const int d = 8 * g + 4 * hi;
        const u32x2 g0 = *(const u32x2*)(gpt + d), g1 = *(const u32x2*)(gpt + 32 + d);
        const float ga[4] = {bflo(g0.x), bfhi(g0.x), bflo(g0.y), bfhi(g0.y)};
        const float gb[4] = {bflo(g1.x), bfhi(g1.x), bflo(g1.y), bfhi(g1.y)};
        float ya[4], yb[4];
#pragma unroll
        for (int e = 0; e < 4; ++e) { ya[e] = o0[4 * g + e] * inv * ga[e] * sigm(ga[e]); yb[e] = o1[4 * g + e] * inv * gb[e] * sigm(gb[e]); }
        u32x2 wa, wb; wa.x = cvtpk(ya[0], ya[1]); wa.y = cvtpk(ya[2], ya[3]); wb.x = cvtpk(yb[0], yb[1]); wb.y = cvtpk(yb[2], yb[3]);
        *(LAS u32x2*)(stg + r32 * 144 + d * 2) = wa; *(LAS u32x2*)(stg + r32 * 144 + 64 + d * 2) = wb;
    }
    LDS_WAIT();
#pragma unroll
    for (int i = 0; i < 4; ++i) {
        const int row = 8 * i + (lane >> 3), ch = lane & 7;
        const u32x4 w = *(const LAS u32x4*)(stg + row * 144 + ch * 16);
        *(u32x4*)(Y + (rowbase + qw0 + row) * DM + (MODE ? 256 : 0) + h * 64 + ch * 8) = w;
    }
}

constexpr size_t WS_AG = WS_XB, WS_QG = WS_XB + 8 * MiB, WS_DG = WS_XB + 16 * MiB, WS_Y0 = 236 * MiB;
constexpr int L_CUM = 0, L_AF = 16384, L_MAB = 32768, L_AT = 49152, L_BT = 58368, L_KT = 67584, L_RT = 76800, L_VT = 86016, L_BH = 95232, L_KH = 104448,
              L_MAK = 113664, L_MRB = 122880, L_MRK = 132096, L_GC = 141312;
__device__ __forceinline__ int crow(int r, int hi) { return (r & 3) + 8 * (r >> 2) + 4 * hi; }
__device__ __forceinline__ float rowsum16(float x) { x += dpp_f<0xB1>(x); x += dpp_f<0x4E>(x); x += dpp_f<0x141>(x); x += dpp_f<0x140>(x); return x; }
__device__ __forceinline__ float wsum(float x) {
    x = rowsum16(x);
    const int xi = __builtin_bit_cast(int, x);
    return (__builtin_bit_cast(float, __builtin_amdgcn_readlane(xi, 0)) + __builtin_bit_cast(float, __builtin_amdgcn_readlane(xi, 16))) +
           (__builtin_bit_cast(float, __builtin_amdgcn_readlane(xi, 32)) + __builtin_bit_cast(float, __builtin_amdgcn_readlane(xi, 48)));
}
__device__ __forceinline__ f32x16 mm32(f32x16 acc, const LAS unsigned char* A, const LAS unsigned char* B, int tm, int tn, int r32, int hi) {
    const LAS unsigned char* ap = A + (32 * tm + r32) * 144 + hi * 16; const LAS unsigned char* bp = B + (32 * tn + r32) * 144 + hi * 16;
#pragma unroll
    for (int ks = 0; ks < 4; ++ks) acc = __builtin_amdgcn_mfma_f32_32x32x16_bf16(*(const LAS bf16x8*)(ap + ks * 32), *(const LAS bf16x8*)(bp + ks * 32), acc, 0, 0, 0);
    return acc;
}
__device__ __forceinline__ f32x4 mm16(f32x4 acc, const LAS unsigned char* A, int arow0, const LAS unsigned char* B, int brow0, int l15, int lq) {
    const LAS unsigned char* ap = A + (arow0 + l15) * 144 + lq * 16; const LAS unsigned char* bp = B + (brow0 + l15) * 144 + lq * 16;
#pragma unroll
    for (int ks = 0; ks < 2; ++ks) acc = __builtin_amdgcn_mfma_f32_16x16x32_bf16(*(const LAS bf16x8*)(ap + ks * 64), *(const LAS bf16x8*)(bp + ks * 64), acc, 0, 0, 0);
    return acc;
}
__device__ __forceinline__ void st16(LAS unsigned char* lds, int region, int row, int col, float v) { *(LAS bf16_t*)(lds + region + row * 144 + col * 2) = (bf16_t)(cvtpk(v, 0.f) & 0xffffu); }

struct PrepRegs { u32x4 cu, pv; };
__device__ __forceinline__ void rwkv_prep_loads(PrepRegs& R, int l, const bf16_t* P, const unsigned char* ws, int cid) {
    const int tid = tid_fresh();
    const int bh = cid >> 7, cc = cid & 127, b = bh >> 2;
    const size_t tok0 = (size_t)b * SEQ + cc * 64;
    {
        const int t = tid >> 3, seg = tid & 7;
        const bf16_t* pr = P + (tok0 + t) * NP + T_MISC * 256 + 8 * seg;
        R.cu = *(const u32x4*)pr;
        u32x4 z = {0u, 0u, 0u, 0u}; R.pv = z;
        if (cc * 64 + t > 0) R.pv = *(const u32x4*)(pr - NP);
    }
}
__device__ __forceinline__ void rwkv_prep_item(LAS unsigned char* lds, KArgs* a, int l, const bf16_t* P, bf16_t* Y, unsigned char* ws, int cid, const PrepRegs& R) {
    const int tid = tid_fresh(), lane = tid & 63, r32 = lane & 31, hi = lane >> 5;
    const int wid = __builtin_amdgcn_readfirstlane(tid >> 6);
    const int bh = cid >> 7, cc = cid & 127, b = bh >> 2, h = bh & 3;
    const size_t tok0 = (size_t)b * SEQ + cc * 64;
    const int c = h * 64 + lane;
    const float* mu = a->in[4] + l * 832;
    const float mu_r = mu[c], mu_k = mu[256 + c], mu_v = mu[512 + c];
    const float w0c = a->in[5][l * 256 + c], a0c = a->in[7][l * 256 + c], kkc = a->in[9][l * 256 + c], kac = a->in[10][l * 256 + c], rkc = a->in[11][l * 256 + c];
    const int l15 = lane & 15, lq = lane >> 4;
    bf16x8 bwv[2], bav[2];
    {
        const bf16_t* w2T = (const bf16_t*)(ws + WS_LORA) + (size_t)(l * 2 + 0) * 8192; const bf16_t* a2T = (const bf16_t*)(ws + WS_LORA) + (size_t)(l * 2 + 1) * 8192;
#pragma unroll
        for (int q = 0; q < 2; ++q) {
            const int nt = (wid >> 2) * 2 + q;
            bwv[q] = *(const bf16x8*)(w2T + (h * 64 + 16 * nt + l15) * 32 + 8 * lq);
            bav[q] = *(const bf16x8*)(a2T + (h * 64 + 16 * nt + l15) * 32 + 8 * lq);
        }
    }
    float r9[9], k9[9], v9[9];
    {
        const bf16_t* p0 = P + (tok0 + 8 * wid) * NP + c;
#pragma unroll
        for (int n = 0; n < 9; ++n) {
            const bool ok = (n > 0) || (cc * 64 + 8 * wid > 0);
            const bf16_t* pr = p0 + (ptrdiff_t)(n - 1) * NP;
            r9[n] = ok ? bf2f(pr[T_RR * 256]) : 0.f; k9[n] = ok ? bf2f(pr[T_RK * 256]) : 0.f; v9[n] = ok ? bf2f(pr[T_RV * 256]) : 0.f;
        }
    }
    {
        const int t = tid >> 3, seg = tid & 7;
        const u32x4 cu = R.cu, pv = R.pv;
        const f32x4 m0 = *(const f32x4*)(mu + 768 + 8 * seg), m1 = *(const f32x4*)(mu + 768 + 8 * seg + 4);
        float v[8] = {bflo(cu.x), bfhi(cu.x), bflo(cu.y), bfhi(cu.y), bflo(cu.z), bfhi(cu.z), bflo(cu.w), bfhi(cu.w)};
        const float q[8] = {bflo(pv.x), bfhi(pv.x), bflo(pv.y), bfhi(pv.y), bflo(pv.z), bfhi(pv.z), bflo(pv.w), bfhi(pv.w)};
#pragma unroll
        for (int e = 0; e < 8; ++e) { v[e] += (q[e] - v[e]) * (e < 4 ? m0[e] : m1[e - 4]); if (seg < 4) v[e] = tanh_(v[e]); }
        *(LAS bf16x8*)(lds + L_MAK + t * 144 + seg * 16) = pack8(v[0], v[1], v[2], v[3], v[4], v[5], v[6], v[7]);
    }
    BAR_LDS();
    {
        const int rt = wid & 3;
        const bf16x8 aw_ = *(const LAS bf16x8*)(lds + L_MAK + (16 * rt + l15) * 144 + lq * 16);
        const bf16x8 aa_ = *(const LAS bf16x8*)(lds + L_MAK + (16 * rt + l15) * 144 + 64 + lq * 16);
        LAS float* AW = (LAS float*)(lds + L_MAB); LAS float* AA = (LAS float*)(lds + L_AF);
#pragma unroll
        for (int q = 0; q < 2; ++q) {
            const int nt = (wid >> 2) * 2 + q;
            const bf16x8 bw_ = bwv[q], ba_ = bav[q];
            f32x4 z = {0.f, 0.f, 0.f, 0.f};
            const f32x4 cw = __builtin_amdgcn_mfma_f32_16x16x32_bf16(aw_, bw_, z, 0, 0, 0);
            const f32x4 ca = __builtin_amdgcn_mfma_f32_16x16x32_bf16(aa_, ba_, z, 0, 0, 0);
#pragma unroll
            for (int rg = 0; rg < 4; ++rg) { AW[(16 * rt + 4 * lq + rg) * 64 + 16 * nt + l15] = cw[rg]; AA[(16 * rt + 4 * lq + rg) * 64 + 16 * nt + l15] = ca[rg]; }
        }
    }
    BAR_LDS();
    float rr[8], kq[8], vv[8], kn[8], bb[8], lwv[8];
    {
        const LAS float* AW = (const LAS float*)(lds + L_MAB); const LAS float* AA = (const LAS float*)(lds + L_AF);
#pragma unroll
        for (int n = 0; n < 8; ++n) {
            const int tk = 8 * wid + n;
            const float r = r9[n + 1] + (r9[n] - r9[n + 1]) * mu_r, k = k9[n + 1] + (k9[n] - k9[n + 1]) * mu_k, v = v9[n + 1] + (v9[n] - v9[n + 1]) * mu_v;
            const float aw = AW[tk * 64 + lane], aa = AA[tk * 64 + lane];

            const float alpha = sigm(a0c + aa);
            const float kkr = k * kkc;
            const float ssq = wsum(kkr * kkr);
            const float kk = kkr * rsqrtf(fmaxf(ssq, 1e-12f));
            const float kmv = k * (1.f + (alpha - 1.f) * kac);
            const float bon = wsum(r * kmv * rkc);
            Y[(tok0 + tk) * DM + 512 + c] = (bf16_t)(cvtpk(bon * v, 0.f) & 0xffffu);
            rr[n] = r; kq[n] = kmv; vv[n] = v; kn[n] = kk; bb[n] = kk * alpha; lwv[n] = -0.60653065971f * sigm(w0c + aw);
        }
    }
    float cumv[8]; float run = 0.f;
#pragma unroll
    for (int n = 0; n < 8; ++n) { run += lwv[n]; cumv[n] = run; }
    LAS float* Ltot = (LAS float*)(lds + L_CUM);
    Ltot[wid * 64 + lane] = run;
    BAR_LDS();
    float off = 0.f, tot = 0.f;
#pragma unroll
    for (int w = 0; w < 8; ++w) { const float tv = Ltot[w * 64 + lane]; if (w < wid) off += tv; tot += tv; }
    float bh8[8], kh8[8];
    const float e_off = __expf(off), e_tot = __expf(tot);
    float e_pos_prev = e_off;
#pragma unroll
    for (int n = 0; n < 8; ++n) {
        const int tk = 8 * wid + n;
        const float cm = cumv[n] + off;
        const float e_pos = __expf(cm), e_neg = __builtin_amdgcn_rcpf(e_pos), e_prev = (n == 0) ? e_off : e_pos_prev, e_end = e_tot * e_neg;
        e_pos_prev = e_pos;
        const float at = -kn[n] * e_prev;
        ((LAS float*)(lds + L_AF))[tk * 64 + lane] = at;
        st16(lds, L_AT, tk, lane, at); st16(lds, L_BT, tk, lane, bb[n] * e_neg); st16(lds, L_KT, tk, lane, kq[n] * e_neg); st16(lds, L_RT, tk, lane, rr[n] * e_pos);
        bh8[n] = bb[n] * e_end; kh8[n] = kq[n] * e_end;
    }
    *(LAS bf16x8*)(lds + L_VT + lane * 144 + 16 * wid) = pack8(vv[0], vv[1], vv[2], vv[3], vv[4], vv[5], vv[6], vv[7]);
    *(LAS bf16x8*)(lds + L_BH + lane * 144 + 16 * wid) = pack8(bh8[0], bh8[1], bh8[2], bh8[3], bh8[4], bh8[5], bh8[6], bh8[7]);
    *(LAS bf16x8*)(lds + L_KH + lane * 144 + 16 * wid) = pack8(kh8[0], kh8[1], kh8[2], kh8[3], kh8[4], kh8[5], kh8[6], kh8[7]);
    if (wid == 0) ((LAS float*)(lds + L_GC))[lane] = __expf(tot);
    BAR_LDS();
    {
        const int p = wid >> 1, tm = wid & 1;
        const int Areg = (p & 1) ? L_KT : L_BT, Breg = (p < 2) ? L_AT : L_RT;
#pragma unroll
        for (int tn = 0; tn < 2; ++tn) {
            f32x16 acc;
#pragma unroll
            for (int r = 0; r < 16; ++r) acc[r] = 0.f;
            const int n_ = 32 * tn + r32, lim_ = n_ + (p >> 1);
            if (tm <= tn) acc = mm32(acc, lds + Areg, lds + Breg, tm, tn, r32, hi);
            if (tm == tn) {
#pragma unroll
                for (int r = 0; r < 16; ++r) { if (!(32 * tm + crow(r, hi) < lim_)) acc[r] = 0.f; }
            }
            if (p == 0) {
#pragma unroll
                for (int g = 0; g < 4; ++g) {
                    LAS float* mrow = (LAS float*)(lds + L_MAB) + n_ * 64 + 8 * tm + 2 * g + hi;
                    mrow[0] = acc[4 * g]; mrow[16] = acc[4 * g + 1]; mrow[32] = acc[4 * g + 2]; mrow[48] = acc[4 * g + 3];
                }
            } else {
                const int dst = (p == 1) ? L_MAK : ((p == 2) ? L_MRB : L_MRK);
#pragma unroll
                for (int g = 0; g < 4; ++g) { u32x2 o; o.x = cvtpk(acc[4 * g], acc[4 * g + 1]); o.y = cvtpk(acc[4 * g + 2], acc[4 * g + 3]); *(LAS u32x2*)(lds + dst + n_ * 144 + (32 * tm + 8 * g + 4 * hi) * 2) = o; }
            }
        }
    }
    BAR_LDS();
    if (wid < 4) {
        const int tm = wid >> 1, tn = wid & 1;
        f32x16 acc;
#pragma unroll
        for (int r = 0; r < 16; ++r) acc[r] = 0.f;
        acc = mm32(acc, lds + L_MAK, lds + L_VT, tm, tn, r32, hi);
        LAS float* X0 = (LAS float*)(lds + L_CUM);
#pragma unroll
        for (int r = 0; r < 16; ++r) X0[(32 * tm + crow(r, hi)) * 64 + 32 * tn + r32] = acc[r];
    }
    BAR_LDS();
#ifndef DIS_SOLVE
    {
        const int p4 = lane & 3, ci = (16 * wid + (lane >> 2)) & 63;
        const LAS float* rhs = (const LAS float*)(lds + ((wid < 4) ? L_AF : L_CUM)) + ci;
        const LAS float* Mb = (const LAS float*)(lds + L_MAB);
        const LAS float* Mp = Mb + 16 * p4;
        float xo[16];
#pragma unroll
        for (int i = 0; i < 16; ++i) xo[i] = 0.f;
#pragma unroll
        for (int rb = 0; rb < 16; ++rb) {
            const int t0 = 4 * rb;
            float a0 = 0.f, a1 = 0.f, a2 = 0.f, a3 = 0.f;
#pragma unroll
            for (int i4 = 0; i4 < (rb + 3) / 4; ++i4) {
                const f32x4 m0 = *(const LAS f32x4*)(Mp + (t0 + 0) * 64 + 4 * i4), m1 = *(const LAS f32x4*)(Mp + (t0 + 1) * 64 + 4 * i4);
                const f32x4 m2 = *(const LAS f32x4*)(Mp + (t0 + 2) * 64 + 4 * i4), m3 = *(const LAS f32x4*)(Mp + (t0 + 3) * 64 + 4 * i4);
#pragma unroll
                for (int e = 0; e < 4; ++e) if (4 * i4 + e < rb) { a0 += m0[e] * xo[4 * i4 + e]; a1 += m1[e] * xo[4 * i4 + e]; a2 += m2[e] * xo[4 * i4 + e]; a3 += m3[e] * xo[4 * i4 + e]; }
            }
            a0 += dpp_f<0xB1>(a0); a1 += dpp_f<0xB1>(a1); a2 += dpp_f<0xB1>(a2); a3 += dpp_f<0xB1>(a3);
            a0 += dpp_f<0x4E>(a0); a1 += dpp_f<0x4E>(a1); a2 += dpp_f<0x4E>(a2); a3 += dpp_f<0x4E>(a3);
            const float m10 = Mb[(t0 + 1) * 64 + rb], m20 = Mb[(t0 + 2) * 64 + rb], m21 = Mb[(t0 + 2) * 64 + 16 + rb];
            const float m30 = Mb[(t0 + 3) * 64 + rb], m31 = Mb[(t0 + 3) * 64 + 16 + rb], m32 = Mb[(t0 + 3) * 64 + 32 + rb];
            const float x0 = a0 + rhs[(t0 + 0) * 64];
            const float x1 = a1 + rhs[(t0 + 1) * 64] + m10 * x0;
            const float x2 = a2 + rhs[(t0 + 2) * 64] + m20 * x0 + m21 * x1;
            const float x3 = a3 + rhs[(t0 + 3) * 64] + m30 * x0 + m31 * x1 + m32 * x2;
            xo[rb] = (p4 == 0) ? x0 : ((p4 == 1) ? x1 : ((p4 == 2) ? x2 : x3));
        }
        LAS unsigned char* dst = lds + ((wid < 4) ? L_AT : L_BT) + ci * 144 + p4 * 2;
#pragma unroll
        for (int i = 0; i < 16; ++i) *(LAS bf16_t*)(dst + i * 8) = (bf16_t)(cvtpk(xo[i], 0.f) & 0xffffu);
    }
#endif
    BAR_LDS();
    bf16_t* AG = (bf16_t*)(ws + WS_AG) + (size_t)cid * 4096; bf16_t* QG = (bf16_t*)(ws + WS_QG) + (size_t)cid * 4096;
    bf16_t* DG = (bf16_t*)(ws + WS_DG) + (size_t)cid * 4096; bf16_t* Y0G = (bf16_t*)(ws + WS_Y0) + (size_t)cid * 4096;
    if (wid < 4) {
        const int tm = wid >> 1, tn = wid & 1, n_ = 32 * tn + r32;
        f32x16 acc;
#pragma unroll
        for (int g = 0; g < 4; ++g) { const u32x2 rv = *(const LAS u32x2*)(lds + L_RT + n_ * 144 + (32 * tm + 8 * g + 4 * hi) * 2); acc[4 * g] = bflo(rv.x); acc[4 * g + 1] = bfhi(rv.x); acc[4 * g + 2] = bflo(rv.y); acc[4 * g + 3] = bfhi(rv.y); }
        acc = mm32(acc, lds + L_AT, lds + L_MRB, tm, tn, r32, hi);
        bf16_t* qg = QG + n_ * 64 + 32 * tm + 4 * hi;
#pragma unroll
        for (int g = 0; g < 4; ++g) { u32x2 o; o.x = cvtpk(acc[4 * g], acc[4 * g + 1]); o.y = cvtpk(acc[4 * g + 2], acc[4 * g + 3]); *(u32x2*)(qg + 8 * g) = o; }
        f32x16 d;
#pragma unroll
        for (int r = 0; r < 16; ++r) d[r] = 0.f;
        d = mm32(d, lds + L_BH, lds + L_BT, tm, tn, r32, hi);
        d = mm32(d, lds + L_KH, lds + L_VT, tm, tn, r32, hi);
        bf16_t* dg = DG + (wid * 128 + lane) * 8;
        *(bf16x8*)dg = pack8(d[0], d[1], d[2], d[3], d[4], d[5], d[6], d[7]);
        *(bf16x8*)(dg + 512) = pack8(d[8], d[9], d[10], d[11], d[12], d[13], d[14], d[15]);
    } else {
        const int w4 = wid - 4, tm = w4 >> 1, tn = w4 & 1, n_ = 32 * tn + r32;
        f32x16 acc;
        const float gc = ((const LAS float*)(lds + L_GC))[n_];
#pragma unroll
        for (int r = 0; r < 16; ++r) acc[r] = (32 * tm + crow(r, hi) == n_) ? gc : 0.f;
        acc = mm32(acc, lds + L_AT, lds + L_BH, tm, tn, r32, hi);
        bf16_t* ag = AG + n_ * 64 + 32 * tm + 4 * hi;
#pragma unroll
        for (int g = 0; g < 4; ++g) { u32x2 o; o.x = cvtpk(acc[4 * g], acc[4 * g + 1]); o.y = cvtpk(acc[4 * g + 2], acc[4 * g + 3]); *(u32x2*)(ag + 8 * g) = o; }
        const int l15 = lane & 15, lq = lane >> 4;
#pragma unroll
        for (int nt = 0; nt < 4; ++nt) {
            f32x4 y = {0.f, 0.f, 0.f, 0.f};
            y = mm16(y, lds + L_MRB, 16 * w4, lds + L_BT, 16 * nt, l15, lq);
            y = mm16(y, lds + L_MRK, 16 * w4, lds + L_VT, 16 * nt, l15, lq);
            bf16_t* yg = Y0G + ((w4 * 4 + nt) * 4) * 64 + lane;
#pragma unroll
            for (int rg = 0; rg < 4; ++rg) yg[rg * 64] = (bf16_t)(cvtpk(y[rg], 0.f) & 0xffffu);
        }
    }
    BAR_LDS();
}

constexpr size_t WS_HG = 244 * MiB, WS_GW = 252 * MiB;
__device__ __forceinline__ void rwkv_chain_item(LAS unsigned char* lds, const unsigned char* ws_c, unsigned char* ws, int bh) {
    constexpr int RBASE = 18432, SLOT = 17408;
    const int tid = tid_fresh(), lane = tid & 63, r32 = lane & 31, hi = lane >> 5;
    const int wid = __builtin_amdgcn_readfirstlane(tid >> 6);
    const int t2 = tid & 255;
    const bf16_t* AG = (const bf16_t*)(ws_c + WS_AG) + (size_t)bh * 128 * 4096;
    const bf16_t* DG = (const bf16_t*)(ws_c + WS_DG) + (size_t)bh * 128 * 4096;
    bf16_t* HG = (bf16_t*)(ws + WS_HG) + (size_t)bh * 128 * 4096;
    for (int i = tid; i < 2 * 9216 / 4; i += NTHR) ((LAS unsigned*)lds)[i] = 0u;
    u32x4 B0a0, B0a1, B0d0, B0d1, B1a0, B1a1, B1d0, B1d1, B2a0, B2a1, B2d0, B2d1, B3a0, B3a1, B3d0, B3d1, B4a0, B4a1, B4d0, B4d1, B5a0, B5a1, B5d0, B5d1, B6a0, B6a1, B6d0, B6d1;
#define CB_LOAD(X, cc_) do { if ((cc_) < 128) { const size_t co_ = (size_t)(cc_) * 4096; X##a0 = *(const u32x4*)(AG + co_ + t2 * 8); X##a1 = *(const u32x4*)(AG + co_ + 2048 + t2 * 8); \
        X##d0 = *(const u32x4*)(DG + co_ + t2 * 8); X##d1 = *(const u32x4*)(DG + co_ + 2048 + t2 * 8); } } while (0)
#define CB_STORE(X, k_) do { LAS unsigned char* sb_ = lds + RBASE + (k_) * SLOT; \
        *(LAS u32x4*)(sb_ + (t2 >> 3) * 144 + (t2 & 7) * 16) = X##a0; *(LAS u32x4*)(sb_ + (32 + (t2 >> 3)) * 144 + (t2 & 7) * 16) = X##a1; \
        *(LAS u32x4*)(sb_ + 9216 + t2 * 16) = X##d0; *(LAS u32x4*)(sb_ + 9216 + 4096 + t2 * 16) = X##d1; } while (0)
#define CB_STEP(k_, c_) do { if ((c_) < 128) { if (wid < 4) { const LAS unsigned char* sb = lds + RBASE + (k_) * SLOT; const LAS unsigned char* Sc = lds + ((c_) & 1) * 9216; LAS unsigned char* Sn = lds + (((c_) & 1) ^ 1) * 9216; \
            const int tm = wid >> 1, tn = wid & 1; f32x16 acc, acc2; const LAS u32x4* dp = (const LAS u32x4*)(sb + 9216 + (wid * 128 + lane) * 16); \
            { const u32x4 da = dp[0], db = dp[64]; \
              acc[0] = bflo(da.x); acc[1] = bfhi(da.x); acc[2] = bflo(da.y); acc[3] = bfhi(da.y); acc[4] = bflo(da.z); acc[5] = bfhi(da.z); acc[6] = bflo(da.w); acc[7] = bfhi(da.w); \
              acc[8] = bflo(db.x); acc[9] = bfhi(db.x); acc[10] = bflo(db.y); acc[11] = bfhi(db.y); acc[12] = bflo(db.z); acc[13] = bfhi(db.z); acc[14] = bflo(db.w); acc[15] = bfhi(db.w); } \
            _Pragma("unroll") for (int r = 0; r < 16; ++r) acc2[r] = 0.f; \
            { const LAS unsigned char* ap = sb + (32 * tm + r32) * 144 + hi * 16; const LAS unsigned char* bp = Sc + (32 * tn + r32) * 144 + hi * 16; \
              acc = __builtin_amdgcn_mfma_f32_32x32x16_bf16(*(const LAS bf16x8*)(ap), *(const LAS bf16x8*)(bp), acc, 0, 0, 0); \
              acc2 = __builtin_amdgcn_mfma_f32_32x32x16_bf16(*(const LAS bf16x8*)(ap + 64), *(const LAS bf16x8*)(bp + 64), acc2, 0, 0, 0); \
              acc = __builtin_amdgcn_mfma_f32_32x32x16_bf16(*(const LAS bf16x8*)(ap + 32), *(const LAS bf16x8*)(bp + 32), acc, 0, 0, 0); \
              acc2 = __builtin_amdgcn_mfma_f32_32x32x16_bf16(*(const LAS bf16x8*)(ap + 96), *(const LAS bf16x8*)(bp + 96), acc2, 0, 0, 0); } \
            _Pragma("unroll") for (int r = 0; r < 16; ++r) acc[r] += acc2[r]; \
            const u32x4 h0_ = *(const LAS u32x4*)(Sc + (t2 >> 3) * 144 + (t2 & 7) * 16), h1_ = *(const LAS u32x4*)(Sc + (32 + (t2 >> 3)) * 144 + (t2 & 7) * 16); \
            _Pragma("unroll") for (int g = 0; g < 4; ++g) { u32x2 o; o.x = cvtpk(acc[4 * g], acc[4 * g + 1]); o.y = cvtpk(acc[4 * g + 2], acc[4 * g + 3]); *(LAS u32x2*)(Sn + (32 * tn + r32) * 144 + (32 * tm + 8 * g + 4 * hi) * 2) = o; } \
            *(u32x4*)(HG + (size_t)(c_) * 4096 + t2 * 8) = h0_; *(u32x4*)(HG + (size_t)(c_) * 4096 + 2048 + t2 * 8) = h1_; } \
        BAR_LDS(); } } while (0)
#define CB_FEED(X, k_, c_) do { if (wid >= 4) { if ((c_) + 7 < 128) CB_STORE(X, k_); CB_LOAD(X, (c_) + 14); } } while (0)
    if (wid >= 4) {
        CB_LOAD(B0, 0); CB_LOAD(B1, 1); CB_LOAD(B2, 2); CB_LOAD(B3, 3); CB_LOAD(B4, 4); CB_LOAD(B5, 5); CB_LOAD(B6, 6);
        CB_STORE(B0, 0); CB_STORE(B1, 1); CB_STORE(B2, 2); CB_STORE(B3, 3); CB_STORE(B4, 4); CB_STORE(B5, 5); CB_STORE(B6, 6);
        CB_LOAD(B0, 7); CB_LOAD(B1, 8); CB_LOAD(B2, 9); CB_LOAD(B3, 10); CB_LOAD(B4, 11); CB_LOAD(B5, 12); CB_LOAD(B6, 13);
    }
    BAR_LDS();
#pragma unroll 1
    for (int bk = 0; bk < 19; ++bk) {
        const int c0 = 7 * bk;
        CB_STEP(0, c0); CB_FEED(B0, 0, c0);
        CB_STEP(1, c0 + 1); CB_FEED(B1, 1, c0 + 1);
        CB_STEP(2, c0 + 2); CB_FEED(B2, 2, c0 + 2);
        CB_STEP(3, c0 + 3); CB_FEED(B3, 3, c0 + 3);
        CB_STEP(4, c0 + 4); CB_FEED(B4, 4, c0 + 4);
        CB_STEP(5, c0 + 5); CB_FEED(B5, 5, c0 + 5);
        CB_STEP(6, c0 + 6); CB_FEED(B6, 6, c0 + 6);
    }
#undef CB_FEED
#undef CB_LOAD
#undef CB_STORE
#undef CB_STEP
}
__device__ __forceinline__ void rwkv_out_pair(KArgs* a, int l, const bf16_t* P, bf16_t* Y, const unsigned char* ws, int item0, int item1, int lane) {
    const int l15 = lane & 15, lq = lane >> 4;
    bf16x8 qa[2][2], hb[2][4][2]; bf16_t y0[2][4][4];
    size_t tokb[2]; int hh[2];
#pragma unroll
    for (int u = 0; u < 2; ++u) {
        const int item = (u && item1 >= 0) ? item1 : item0;
        const int cid = item >> 2, w4 = item & 3;
        const int bh = cid >> 7, cc = cid & 127, b = bh >> 2, h = bh & 3;
        hh[u] = h; tokb[u] = (size_t)b * SEQ + cc * 64 + 16 * w4 + 4 * lq;
        const bf16_t* QG = (const bf16_t*)(ws + WS_QG) + (size_t)cid * 4096; const bf16_t* HG = (const bf16_t*)(ws + WS_HG) + (size_t)cid * 4096;
        const bf16_t* Y0G = (const bf16_t*)(ws + WS_Y0) + (size_t)cid * 4096;
#pragma unroll
        for (int ks = 0; ks < 2; ++ks) qa[u][ks] = *(const bf16x8*)(QG + (16 * w4 + l15) * 64 + 32 * ks + 8 * lq);
#pragma unroll
        for (int nt = 0; nt < 4; ++nt) {
#pragma unroll
            for (int ks = 0; ks < 2; ++ks) hb[u][nt][ks] = *(const bf16x8*)(HG + (16 * nt + l15) * 64 + 32 * ks + 8 * lq);
            const bf16_t* yp = Y0G + ((w4 * 4 + nt) * 4) * 64 + lane;
#pragma unroll
            for (int rg = 0; rg < 4; ++rg) {
                y0[u][nt][rg] = yp[rg * 64];
            }
        }
    }
#pragma unroll
    for (int u = 0; u < 2; ++u) {
        if (u == 1 && item1 < 0) break;
        const int h = hh[u];
        bf16_t ev[4][4], gv[4][4];
#pragma unroll
        for (int nt = 0; nt < 4; ++nt)
#pragma unroll
            for (int rg = 0; rg < 4; ++rg) { const int ch = h * 64 + 16 * nt + l15; ev[nt][rg] = Y[(tokb[u] + rg) * DM + 512 + ch]; gv[nt][rg] = P[(tokb[u] + rg) * NP + T_RG * 256 + ch]; }
        f32x4 y[4];
#pragma unroll
        for (int nt = 0; nt < 4; ++nt) {
#pragma unroll
            for (int rg = 0; rg < 4; ++rg) y[nt][rg] = bf2f(y0[u][nt][rg]);
#pragma unroll
            for (int ks = 0; ks < 2; ++ks) y[nt] = __builtin_amdgcn_mfma_f32_16x16x32_bf16(qa[u][ks], hb[u][nt][ks], y[nt], 0, 0, 0);
        }
        float lng[4], lnb[4];
#pragma unroll
        for (int nt = 0; nt < 4; ++nt) { lng[nt] = a->in[12][l * 256 + h * 64 + 16 * nt + l15]; lnb[nt] = a->in[13][l * 256 + h * 64 + 16 * nt + l15]; }
#pragma unroll
        for (int rg = 0; rg < 4; ++rg) {
            const float mean = rowsum16((y[0][rg] + y[1][rg]) + (y[2][rg] + y[3][rg])) * (1.f / 64.f);
            const float d0 = y[0][rg] - mean, d1 = y[1][rg] - mean, d2 = y[2][rg] - mean, d3 = y[3][rg] - mean;
            const float rs = rsqrtf(rowsum16((d0 * d0 + d1 * d1) + (d2 * d2 + d3 * d3)) * (1.f / 64.f) + 64e-5f);
            const float dd[4] = {d0, d1, d2, d3};
#pragma unroll
            for (int nt = 0; nt < 4; ++nt) {
                const int ch = h * 64 + 16 * nt + l15;
                const float e = bf2f(ev[nt][rg]), g = bf2f(gv[nt][rg]);
                const float ov = (dd[nt] * rs * lng[nt] + lnb[nt] + e) * g * sigm(g);
                Y[(tokb[u] + rg) * DM + 512 + ch] = (bf16_t)(cvtpk(ov, 0.f) & 0xffffu);
            }
        }
    }
}

__device__ __forceinline__ void fgate_item(KArgs* a, int l, const bf16_t* P, unsigned char* ws, int it, int lane) {
    float* Fl = (float*)(ws + WS_FL); float* Ftot = (float*)(ws + WS_FTOT);
    const int bh = it >> 5, cch = it & 31, b = bh >> 2, h = bh & 3;
    const float bfg = a->in[3][l * 4 + h];
    float v[4];
#pragma unroll
    for (int e = 0; e < 4; ++e) {
        const size_t t = (size_t)b * SEQ + cch * 256 + 4 * lane + e;
        const float xx = bf2f(P[t * NP + T_MISC * 256 + 64 + h]) + bfg;
        v[e] = (fminf(xx, 0.f) - __logf(1.f + __expf(-fabsf(xx)))) * LOG2E;
    }
    v[1] += v[0]; v[2] += v[1]; v[3] += v[2];
    const float tot = v[3]; float inc = tot;
#pragma unroll
    for (int o = 1; o < 64; o <<= 1) { const float nb = __shfl_up(inc, o); if (lane >= o) inc += nb; }
    const float ex = inc - tot;
    f32x4 o4 = {v[0] + ex, v[1] + ex, v[2] + ex, v[3] + ex};
    *(f32x4*)(Fl + (size_t)bh * SEQ + cch * 256 + 4 * lane) = o4;
    if (lane == 63) Ftot[bh * 32 + cch] = inc;
    float km = 0.f;
#pragma unroll
    for (int e = 0; e < 4; ++e) {
        const bf16_t* kp = P + ((size_t)b * SEQ + cch * 256 + 4 * lane + e) * NP + 256 + h * 64;
        float s2 = 0.f;
#pragma unroll
        for (int i = 0; i < 8; ++i) { const u32x4 kv = *(const u32x4*)(kp + 8 * i);
            s2 += (bflo(kv.x) * bflo(kv.x) + bfhi(kv.x) * bfhi(kv.x)) + (bflo(kv.y) * bflo(kv.y) + bfhi(kv.y) * bfhi(kv.y)) + (bflo(kv.z) * bflo(kv.z) + bfhi(kv.z) * bfhi(kv.z)) + (bflo(kv.w) * bflo(kv.w) + bfhi(kv.w) * bfhi(kv.w)); }
        km = fmaxf(km, s2);
    }
#pragma unroll
    for (int o = 1; o < 64; o <<= 1) km = fmaxf(km, __shfl_xor(km, o));
    if (lane == 0) ((float*)(ws + WS_KMAX))[bh * 32 + cch] = km;
}

__device__ __forceinline__ void lru_prep_item(LAS unsigned char* lds, KArgs* a, int l, const bf16_t* P, float* LH, float* LA, const unsigned char* ws, unsigned char* ws_w, int q) {
    constexpr int XP = 528;
    const int tid = tid_fresh(), lane = tid & 63, r32 = lane & 31, hi = lane >> 5;
    const int wid = __builtin_amdgcn_readfirstlane(tid >> 6);
    LAS unsigned char* XB_ = lds;
    LAS float* U = (LAS float*)(lds + 34816);
    LAS bf16_t* LA16 = (LAS bf16_t*)(lds + 100352);
    const int c = tid & 255, th = tid >> 8;
    const int t0 = q * 64, b = t0 / SEQ, s0 = t0 % SEQ;
    bf16x8 gba[2][4], gbx[2][4];
    {
        const int n = wid >> 1;
        const bf16_t* WA = (const bf16_t*)(ws + WS_GW) + (size_t)((l * 2 + 0) * 4 + n) * 4096; const bf16_t* WX = (const bf16_t*)(ws + WS_GW) + (size_t)((l * 2 + 1) * 4 + n) * 4096;
#pragma unroll
        for (int tn = 0; tn < 2; ++tn)
#pragma unroll
            for (int ks = 0; ks < 4; ++ks) { gba[tn][ks] = *(const bf16x8*)(WA + (32 * tn + r32) * 64 + 16 * ks + 8 * hi); gbx[tn][ks] = *(const bf16x8*)(WX + (32 * tn + r32) * 64 + 16 * ks + 8 * hi); }
    }
    {
        const float* cw = a->in[14] + l * 4 * 256; const float cb = a->in[15][l * 256 + c];
        const float cw0 = cw[c], cw1 = cw[256 + c], cw2 = cw[512 + c], cw3 = cw[768 + c];
        const int sb = s0 + th * 32;
        const bf16_t* px = P + (size_t)b * SEQ * NP + T_LX * 256 + c;
        float xv[35];
#pragma unroll
        for (int i = 0; i < 35; ++i) { const int sx = sb - 3 + i; xv[i] = (sx >= 0) ? bf2f(px[(ptrdiff_t)sx * NP]) : 0.f; }
#pragma unroll
        for (int tk = 0; tk < 32; ++tk) {
            const float v = cb + cw0 * xv[tk] + cw1 * xv[tk + 1] + cw2 * xv[tk + 2] + cw3 * xv[tk + 3];
            *(LAS bf16_t*)(XB_ + (th * 32 + tk) * XP + c * 2) = (bf16_t)(cvtpk(v, 0.f) & 0xffffu);
        }
    }
    BAR_LDS();
    {
        const int n = wid >> 1, tm = wid & 1;
#pragma unroll
        for (int tn = 0; tn < 2; ++tn) {
            f32x16 ca, cx;
#pragma unroll
            for (int r = 0; r < 16; ++r) { ca[r] = 0.f; cx[r] = 0.f; }
#pragma unroll
            for (int ks = 0; ks < 4; ++ks) {
                const bf16x8 av = *(const LAS bf16x8*)(XB_ + (32 * tm + r32) * XP + (n * 64 + 16 * ks + 8 * hi) * 2);
                const bf16x8 ba = gba[tn][ks], bx = gbx[tn][ks];
                ca = __builtin_amdgcn_mfma_f32_32x32x16_bf16(av, ba, ca, 0, 0, 0);
                cx = __builtin_amdgcn_mfma_f32_32x32x16_bf16(av, bx, cx, 0, 0, 0);
            }
            const int ch = n * 64 + 32 * tn + r32;
            const float bav = a->in[17][l * 256 + ch], bxv = a->in[19][l * 256 + ch], lsp = softplus_(-a->in[20][l * 256 + ch]);
#pragma unroll
            for (int r = 0; r < 16; ++r) {
                const int t = 32 * tm + (r & 3) + 8 * (r >> 2) + 4 * hi;
                const float rg = sigm(ca[r] + bav), ig = sigm(cx[r] + bxv);
                const float la = -8.f * rg * lsp;
                const float xcv = bf2f(*(const LAS bf16_t*)(XB_ + t * XP + ch * 2));
                U[t * 256 + ch] = __builtin_amdgcn_sqrtf(1.f - __expf(2.f * la)) * ig * xcv;
                LA16[t * 256 + ch] = (bf16_t)(cvtpk(la, 0.f) & 0xffffu);
            }
        }
    }
    BAR_LDS();
    if (wid == 4) fgate_item(a, l, P, ws_w, q, lane);
    if (tid < 256) {
        float h = 0.f, sl = 0.f;
#pragma unroll 8
        for (int t = 0; t < 64; ++t) {
            const float la = bf2f(LA16[t * 256 + c]);
            h = __expf(la) * h + U[t * 256 + c]; sl += la;
            const size_t o = (size_t)(t0 + t) * 256 + c;
            LH[o] = h; LA[o] = __expf(sl);
        }
    }
    BAR_LDS();
}
__device__ __forceinline__ void lru_carry_item(const float* LH, const float* LA, float* HIN) {
    const int tid = tid_fresh(), c = tid & 255, b = tid >> 8;
    float hin = 0.f;
#pragma unroll 8
    for (int cc = 0; cc < 128; ++cc) {
        const int q = b * 128 + cc;
        HIN[q * 256 + c] = hin;
        const size_t o = (size_t)(q * 64 + 63) * 256 + c;
        hin = LA[o] * hin + LH[o];
    }
}
__device__ __forceinline__ void lru_apply_item(const bf16_t* P, bf16_t* Y, const float* LH, const float* LA, const float* HIN, int q) {
    const int tid = tid_fresh(), c = tid & 255, th = tid >> 8;
    const float hin = HIN[q * 256 + c];
    const int t0 = q * 64 + th * 32;
#pragma unroll
    for (int tk = 0; tk < 32; ++tk) {
        const size_t t = (size_t)(t0 + tk);
        const float hv = LH[t * 256 + c] + LA[t * 256 + c] * hin;
        const float g = bf2f(P[t * NP + T_LG * 256 + c]);
        const float out = hv * g * sigm(g);
        Y[t * DM + 768 + c] = (bf16_t)(cvtpk(out, 0.f) & 0xffffu);
    }
}

#define XB_TMO      128
#define XB_XCNT(j)  (256  + 64 * (j))
#define XB_XSUB(j)  (1280 + 64 * (j))
#define XB_XGEN(j)  (2304 + 64 * (j))
#define XB_TOP      3328
#define XB_TOPGEN   3392
#define XCD_BAR_WORDS 3456
#define XB_SPIN_CAP (1u << 18)

__device__ __forceinline__ unsigned xb_ld(unsigned* p)              { return __hip_atomic_load(p, __ATOMIC_RELAXED, __HIP_MEMORY_SCOPE_AGENT); }
__device__ __forceinline__ unsigned xb_add(unsigned* p, unsigned v) { return __hip_atomic_fetch_add(p, v, __ATOMIC_RELAXED, __HIP_MEMORY_SCOPE_AGENT); }
__device__ __forceinline__ unsigned xb_xcc_id() { return (unsigned)__builtin_amdgcn_s_getreg((3 << 11) | 20) & 0xFu; }
#define XB_SPIN(cond, bar) do { unsigned _sp = 0; while (cond) { __builtin_amdgcn_s_sleep(1); \
    if ((++_sp & 255u) == 0u) { if (xb_ld(&(bar)[XB_TMO])) break; if (_sp > XB_SPIN_CAP) { atomicAdd(&(bar)[XB_TMO], 1u); break; } } } } while (0)

struct XcdBarrier {
    unsigned* bar; unsigned x;
    volatile LAS unsigned* st;
};

__device__ __forceinline__ XcdBarrier xcd_barrier_post(unsigned* bar, volatile LAS unsigned* st) {
    XcdBarrier b; b.bar = bar; b.x = xb_xcc_id(); b.st = st;
    if (threadIdx.x == 0) (void)xb_add(&bar[XB_XCNT(b.x)], 1u);
    return b;
}
__device__ __forceinline__ void xcd_barrier_complete(unsigned* bar, unsigned x, unsigned& nloc, unsigned& nx) {
    const unsigned G = gridDim.x * gridDim.y * gridDim.z;
    unsigned sum, cnt, mine, sp = 0u;
    for (;;) {
        sum = 0u; cnt = 0u; mine = 0u;
#pragma unroll
        for (unsigned j = 0; j < 16; ++j) { const unsigned c = xb_ld(&bar[XB_XCNT(j)]); sum += c; cnt += (c > 0u) ? 1u : 0u; mine = (j == x) ? c : mine; }
        if (sum == G) break;
        __builtin_amdgcn_s_sleep(1);
        if ((++sp & 255u) == 0u) { if (xb_ld(&bar[XB_TMO])) break; if (sp > XB_SPIN_CAP) { atomicAdd(&bar[XB_TMO], 1u); break; } }
    }
    nloc = mine > 0u ? mine : 1u; nx = cnt > 0u ? cnt : 1u;
}

__device__ __forceinline__ void xcd_barrier(const XcdBarrier& b) {
    asm volatile("s_waitcnt vmcnt(0)" ::: "memory");
    __syncthreads();
    if (threadIdx.x == 0) {
        unsigned* bar = b.bar;
        __builtin_amdgcn_s_waitcnt(0);
        unsigned nloc = b.st[0], nx = b.st[1];
        if (nloc == 0u) { xcd_barrier_complete(bar, b.x, nloc, nx); b.st[0] = nloc; b.st[1] = nx; }
        const unsigned old = xb_add(&bar[XB_XSUB(b.x)], 1u);
        const unsigned gen = old / nloc;
        if (old + 1u == (gen + 1u) * nloc) {
            __builtin_amdgcn_fence(__ATOMIC_RELEASE, "agent");
            asm volatile("s_waitcnt vmcnt(0)" ::: "memory");
            const unsigned og = xb_add(&bar[XB_TOP], 1u);
            const unsigned tg = og / nx;
            if (og + 1u == (tg + 1u) * nx) xb_add(&bar[XB_TOPGEN], 1u);
            else XB_SPIN(xb_ld(&bar[XB_TOPGEN]) == tg, bar);
            __builtin_amdgcn_fence(__ATOMIC_ACQUIRE, "agent");
            xb_add(&bar[XB_XGEN(b.x)], 1u);
            asm volatile("s_waitcnt vmcnt(0)" ::: "memory");
        } else {
            XB_SPIN(xb_ld(&bar[XB_XGEN(b.x)]) == gen, bar);
            __builtin_amdgcn_fence(__ATOMIC_ACQUIRE, "agent");
            asm volatile("s_waitcnt vmcnt(0)" ::: "memory");
        }
    }
    __syncthreads();
}


constexpr int N_ITEMS = 9 + 512;
__global__ void __launch_bounds__(NTHR, 2) mega_fwd(Args a_unused) {
    extern __shared__ __attribute__((aligned(16))) unsigned char lds_raw[];
    LAS unsigned char* lds = (LAS unsigned char*)lds_raw;
    cg::grid_group grid = cg::this_grid();
    {
        for (int u = threadIdx.x; u < 64; u += NTHR) ((LAS unsigned*)(lds + 143360))[u] = 0u;
        __syncthreads();
    }
    {
        KArgs* a0_ = ARGP();
        (void)xcd_barrier_post((unsigned*)(a0_->ws + WS_BAR), (volatile LAS unsigned*)(lds + 143360 + 64));
    }
#if USE_CG_SYNC
#define GRID_SYNC() grid.sync()
#else
#define GRID_SYNC() do { XcdBarrier b_; b_.bar = (unsigned*)(ARGP()->ws + WS_BAR); b_.x = xb_xcc_id(); b_.st = (volatile LAS unsigned*)(lds + 143360 + 64); xcd_barrier(b_); } while (0)
#endif
#define TID (tid_fresh())
#define LANE (TID & 63)
#define WAVE (__builtin_amdgcn_readfirstlane(TID >> 6))
#define GRID_N ((int)gridDim.x)
#define GW ((int)blockIdx.x * 8 + WAVE)
#define NGW_ (GRID_N * 8)

#ifdef PROBE_P0X2
    for (int rep0_ = 0; rep0_ < 2; ++rep0_)
#endif
    {
        KArgs* a = ARGP(); unsigned char* ws = a->ws;
        unsigned* ctl = (unsigned*)(ws + WS_CTL); float* rowss = (float*)(ws + WS_ROWSS);
        bf16_t* WIN = (bf16_t*)(ws + WS_WIN); bf16_t* WOUT = (bf16_t*)(ws + WS_WOUT); bf16_t* XB = (bf16_t*)(ws + WS_XB);
        const float* x = a->in[0];
        const int tid = TID, lane = LANE, wave = WAVE, G = GRID_N, gw = GW, NGW = NGW_;
        for (int i = blockIdx.x * NTHR + tid; i < 2 * M; i += G * NTHR) rowss[M + i] = 0.f;
        if (blockIdx.x == 0 && tid < 16) ctl[tid] = 0u;
        for (int i = blockIdx.x * NTHR + tid; i < 32768; i += G * NTHR) {
            const int m = i & 31, cch = (i >> 5) & 255, g = (i >> 13) & 1, ll = i >> 14;
            const float v = a->in[g ? 8 : 6][(ll * 32 + m) * 256 + cch];
            ((bf16_t*)(ws + WS_LORA))[i] = (bf16_t)(cvtpk(v, 0.f) & 0xffffu);
        }
        for (int i = blockIdx.x * NTHR + tid; i < 65536; i += G * NTHR) {
            const int ii = i & 63, jj = (i >> 6) & 63, nh = (i >> 12) & 3, g = (i >> 14) & 1, ll = i >> 15;
            const float v = a->in[g ? 18 : 16][((ll * 4 + nh) * 64 + ii) * 64 + jj];
            ((bf16_t*)(ws + WS_GW))[i] = (bf16_t)(cvtpk(v, 0.f) & 0xffffu);
        }
        LAS float* scr = (LAS float*)(lds + wave * 16384);
        for (int it = gw; it < 1920; it += NGW) tr_item(a->in[2], NIN, a->in[1], true, WIN, DM, scr, it / 120, it % 120, lane);
        for (int m0 = gw; m0 < M; m0 += 4 * NGW) {
            f32x4 v[4][4];
#pragma unroll
            for (int u = 0; u < 4; ++u) { const int m = m0 + u * NGW; const f32x4* xr = (const f32x4*)(x + (size_t)(m < M ? m : m0) * DM) + lane;
#pragma unroll
                for (int j = 0; j < 4; ++j) v[u][j] = xr[64 * j]; }
#pragma unroll
            for (int u = 0; u < 4; ++u) { const int m = m0 + u * NGW; if (m >= M) break;
                u32x2* xo = (u32x2*)(XB + (size_t)m * DM) + lane; float ss = 0.f;
#pragma unroll
                for (int j = 0; j < 4; ++j) { const f32x4 t = v[u][j]; ss += (t[0] * t[0] + t[1] * t[1]) + (t[2] * t[2] + t[3] * t[3]); u32x2 w; w.x = cvtpk(t[0], t[1]); w.y = cvtpk(t[2], t[3]); xo[64 * j] = w; }
                ss = wsum(ss);
                if (lane == 0) rowss[m] = ss; }
        }
    }
    if (gridDim.x == 0x7fffffffu) grid.sync();
    GRID_SYNC();

#pragma unroll 1
    for (int l = 0; l < DEPTH; ++l) {
#ifndef DIS_P1
        {
            KArgs* a = ARGP(); unsigned char* ws = a->ws;
            pg8::Gemm g{(const bf16_t*)(ws + WS_XB), (const bf16_t*)(ws + WS_WIN) + (size_t)l * NP * DM, M, NP, DM};
            pg8::StaticOrder S; S.init(M, NP, GRID_N, (int)blockIdx.x);
            EpiIn E{(bf16_t*)(ws + WS_P), (const float*)(ws + WS_ROWSS) + l * M};
            pg8::gemm_phase<EpiIn, pg8::StaticOrder, true, true>(lds, g, S, E);
#ifdef PROBE_P1X2
            __syncthreads();
            pg8::gemm_phase<EpiIn, pg8::StaticOrder, true, true>(lds, g, S, E);
#endif
        }
#endif
        GRID_SYNC();
#ifdef PROBE_SYNC8
        GRID_SYNC(); GRID_SYNC(); GRID_SYNC(); GRID_SYNC();
#endif
#ifndef DIS_P2A
#ifdef PROBE_P2AX2
        for (int rep_ = 0; rep_ < 2; ++rep_)
#endif
        {
            KArgs* a = ARGP(); unsigned char* ws = a->ws;
            const bf16_t* P = (const bf16_t*)(ws + WS_P);
            const int G = GRID_N;
#ifdef PROBE_RWPREPX2
            for (int q = blockIdx.x; q < 1024; q += G) { PrepRegs pr_; rwkv_prep_loads(pr_, l, P, ws, q); rwkv_prep_item(lds, a, l, P, (bf16_t*)(ws + WS_Y), ws, q, pr_); }
#endif
#ifdef PROBE_LRUPREPX2
            for (int q = blockIdx.x; q < 256; q += G) lru_prep_item(lds, a, l, P, (float*)(ws + WS_LH), (float*)(ws + WS_LA), ws, ws, q);
#endif
            PrepRegs cur, nxt;
            if ((int)blockIdx.x < 1024) rwkv_prep_loads(cur, l, P, ws, (int)blockIdx.x);
            for (int q = blockIdx.x; q < 1280; q += G) {
                if (q < 1024) {
                    const int qn = q + G;
                    if (qn < 1024) rwkv_prep_loads(nxt, l, P, ws, qn);
                    rwkv_prep_item(lds, a, l, P, (bf16_t*)(ws + WS_Y), ws, q, cur);
                    if (qn < 1024) cur = nxt;
                } else lru_prep_item(lds, a, l, P, (float*)(ws + WS_LH), (float*)(ws + WS_LA), ws, ws, q - 1024);
            }
        }
#endif
        GRID_SYNC();
#ifndef DIS_P2B
        {
            LAS int* qslot = (LAS int*)(lds + 140 * 1024);
            for (;;) {
                KArgs* a = ARGP(); unsigned char* ws = a->ws;
                const bf16_t* P = (const bf16_t*)(ws + WS_P); bf16_t* Y = (bf16_t*)(ws + WS_Y);
                __syncthreads();
                if (TID == 0) *qslot = (int)atomicAdd((unsigned*)(ws + WS_CTL) + l, 1u);
                __syncthreads();
#ifdef PROBE_ATTX2
                int it = *qslot;
                if (it >= N_ITEMS + 512) break;
                if (it >= N_ITEMS) it -= 512;
#else
                const int it = *qslot;
                if (it >= ((l == 0) ? N_ITEMS + 368 : N_ITEMS)) break;
                if (it >= N_ITEMS) {
                    const int wi = (it - N_ITEMS) * 8 + WAVE;
                    LAS float* scr = (LAS float*)(lds + WAVE * 16384);
                    bf16_t* WIN = (bf16_t*)(ws + WS_WIN); bf16_t* WOUT = (bf16_t*)(ws + WS_WOUT);
                    if (wi < 512) tr_item(a->in[21], DM, nullptr, false, WOUT, DM, scr, wi / 32, wi % 32, LANE);
                    else if (wi < 2432) { const int r = wi - 512; tr_item(a->in[2] + (size_t)DM * NIN, NIN, a->in[1] + DM, true, WIN + (size_t)NP * DM, DM, scr, r / 120, r % 120, LANE); }
                    else { const int r = wi - 2432; tr_item(a->in[21] + (size_t)DM * DM, DM, nullptr, false, WOUT + (size_t)DM * DM, DM, scr, r / 32, r % 32, LANE); }
                    continue;
                }
#endif
                if (it < 8) {
                    rwkv_chain_item(lds, ws, ws, it);
#ifdef PROBE_CHAINX2
                    __syncthreads();
                    rwkv_chain_item(lds, ws, ws, it);
#endif
                }
                else if (it == 8) lru_carry_item((const float*)(ws + WS_LH), (const float*)(ws + WS_LA), (float*)(ws + WS_HIN));
                else {
                    const int aa = it - 9, qb = 31 - (aa >> 4), r = aa & 15, bh = r & 7;
                    const float* Fl = (const float*)(ws + WS_FL); const float* Ftot = (const float*)(ws + WS_FTOT); const float* Kc = (const float*)(ws + WS_KMAX);
                    if (r < 8) attn_unit<1>(lds, P, Y, Fl, Ftot, Kc, bh, qb);
                    else attn_unit<0>(lds, P, Y, Fl, Ftot, Kc, bh, qb);
                }
            }
        }
#endif
        GRID_SYNC();
        {
            KArgs* a = ARGP(); unsigned char* ws = a->ws;
            const bf16_t* P = (const bf16_t*)(ws + WS_P); bf16_t* Y = (bf16_t*)(ws + WS_Y);
            const int lane = LANE, gw = GW, NGW = NGW_;
            for (int it = gw; it < 4096; it += 2 * NGW) { const int it2 = it + NGW; rwkv_out_pair(a, l, P, Y, ws, it, it2 < 4096 ? it2 : -1, lane); }
            for (int q = blockIdx.x; q < 256; q += GRID_N) lru_apply_item(P, Y, (const float*)(ws + WS_LH), (const float*)(ws + WS_LA), (const float*)(ws + WS_HIN), q);
        }
        GRID_SYNC();
#ifndef DIS_P3
        {
            KArgs* a = ARGP(); unsigned char* ws = a->ws;
            pg8::Gemm g{(const bf16_t*)(ws + WS_Y), (const bf16_t*)(ws + WS_WOUT) + (size_t)l * DM * DM, M, DM, DM};
            pg8::StaticOrder S; S.init(M, DM, GRID_N, (int)blockIdx.x);
            EpiOut E{l == 0 ? a->in[0] : (const float*)a->out, l == 0 ? a->out : nullptr, (bf16_t*)(ws + WS_XB), (float*)(ws + WS_ROWSS) + (size_t)(l + 1) * M};
#ifdef PROBE_P3X2
            if (l == 0) { EpiOut E2{a->in[0], a->out, (bf16_t*)(ws + WS_XB), (float*)(ws + WS_HG)}; pg8::gemm_phase<EpiOut, pg8::StaticOrder, true, true>(lds, g, S, E2); __syncthreads(); }
#endif
            pg8::gemm_phase<EpiOut, pg8::StaticOrder, true, true>(lds, g, S, E);
        }
#endif
        GRID_SYNC();
    }
    {
        KArgs* a = ARGP(); unsigned char* ws = a->ws;
        const float* fgm = a->in[22]; float* out = a->out;
        const bf16_t* XB = (const bf16_t*)(ws + WS_XB); const float* rss = (const float*)(ws + WS_ROWSS) + (size_t)DEPTH * M;
        const int lane = LANE, gw = GW, NGW = NGW_;
        for (int m0 = gw; m0 < M; m0 += 4 * NGW) {
            u32x2 v[4][4]; float sq[4];
#pragma unroll
            for (int u = 0; u < 4; ++u) { const int m = m0 + u * NGW; const int mm = (m < M) ? m : m0;
                const u32x2* xr = (const u32x2*)(XB + (size_t)mm * DM) + lane;
#pragma unroll
                for (int j = 0; j < 4; ++j) v[u][j] = xr[64 * j];
                sq[u] = rss[mm]; }
            const f32x4* gr = (const f32x4*)fgm + lane;
            const f32x4 g0 = gr[0], g1 = gr[64], g2 = gr[128], g3 = gr[192];
#pragma unroll
            for (int u = 0; u < 4; ++u) { const int m = m0 + u * NGW; if (m >= M) break;
                const float rs = rsqrtf(sq[u] * (1.f / 1024.f) + 1e-6f);
                f32x4* xw = (f32x4*)(out + (size_t)m * DM) + lane;
                const f32x4 gg[4] = {g0, g1, g2, g3};
#pragma unroll
                for (int j = 0; j < 4; ++j) { const u32x2 p = v[u][j]; f32x4 o = {bflo(p.x), bfhi(p.x), bflo(p.y), bfhi(p.y)}; xw[64 * j] = o * rs * gg[j]; } }
        }
    }
}

extern "C" void kernel_launch(void* const* d_in, const int* in_sizes, int n_in, void* d_out, int out_size, void* d_ws, size_t ws_size, hipStream_t stream) {
    static int grid = 0;
    if (grid == 0) {
        int dev = 0, cus = 0, per_cu = 0;
        hipGetDevice(&dev);
        hipDeviceGetAttribute(&cus, hipDeviceAttributeMultiprocessorCount, dev);
        hipFuncSetAttribute((const void*)mega_fwd, hipFuncAttributeMaxDynamicSharedMemorySize, LDS_BYTES);
        hipOccupancyMaxActiveBlocksPerMultiprocessor(&per_cu, (const void*)mega_fwd, NTHR, LDS_BYTES);
        if (per_cu < 1) per_cu = 1;
        grid = cus * per_cu;
        if (n_in != 23 || ws_size < WS_END) { fprintf(stderr, "kernel_launch: unexpected inputs (n_in %d, ws %zu)\n", n_in, ws_size); }
    }
    (void)hipMemsetAsync(d_ws, 0, 64 * 1024, stream);
    Args a{};
    for (int i = 0; i < 23; ++i) a.in[i] = (const float*)d_in[i];
    a.out = (float*)d_out; a.ws = (unsigned char*)d_ws;
    void* args[] = {&a};
    hipError_t e = hipLaunchCooperativeKernel((const void*)mega_fwd, dim3(grid), dim3(NTHR), args, LDS_BYTES, stream);
    if (e != hipSuccess) fprintf(stderr, "cooperative launch failed: %s (grid %d)\n", hipGetErrorString(e), grid);
}
```
